# Optimizing an MI355X kernel written in HIP

```python
import jax
import jax.numpy as jnp
from jax import lax
import numpy as np


D_MODEL = 1024
BATCH = 4
SEQ = 8192
DEPTH = 4

N_MIXERS = 3
CHUNK = 64
NORM_EPS = 1e-6
RET_HEADS = 4
RET_QK_DIM = D_MODEL // RET_HEADS
RET_V_DIM = 2 * D_MODEL // RET_HEADS
RET_IN = 2 * RET_HEADS * RET_QK_DIM + 2 * RET_HEADS * RET_V_DIM
ROPE_BASE = 10000.0
CONV_WIDTH = 31
GLA_HEADS = 4
GLA_K_DIM = D_MODEL // 2 // GLA_HEADS
GLA_V_DIM = D_MODEL // GLA_HEADS
GLA_IN = 2 * GLA_HEADS * GLA_K_DIM + 2 * GLA_HEADS * GLA_V_DIM
GLA_GATE_RANK = 16
GLA_GATE_NORMALIZER = 16.0
D_FF = 4 * D_MODEL
N_RET = (DEPTH + 2) // 3
N_CONV = (DEPTH + 1) // 3
N_GLA = DEPTH // 3

F32 = jnp.float32

kernel_name = "hybrid_retention_conformer_gla_encoder"


def rmsnorm(x, gain=None):
    xf = x.astype(F32)
    y = xf * lax.rsqrt(jnp.mean(xf * xf, axis=-1, keepdims=True) + NORM_EPS)
    if gain is not None:
        y = y * gain.astype(F32)
    return y.astype(x.dtype)


def layernorm(x, gain, bias):
    xf = x.astype(F32)
    mu = jnp.mean(xf, axis=-1, keepdims=True)
    var = jnp.mean(jnp.square(xf - mu), axis=-1, keepdims=True)
    y = (xf - mu) * lax.rsqrt(var + NORM_EPS) * gain.astype(F32) + bias.astype(F32)
    return y.astype(x.dtype)


def split_heads(t, n):
    b, l, _ = t.shape
    return t.reshape(b, l, n, -1).transpose(0, 2, 1, 3)


def merge_heads(t):
    b, n, l, d = t.shape
    return t.transpose(0, 2, 1, 3).reshape(b, l, n * d)


def rotary(t, positions):
    d = t.shape[-1]
    half = d // 2
    inv_freq = ROPE_BASE ** (-jnp.arange(half, dtype=F32) / half)
    ang = positions.astype(F32)[:, None, :, None] * inv_freq
    cos, sin = jnp.cos(ang), jnp.sin(ang)
    tf = t.astype(F32)
    t1, t2 = tf[..., :half], tf[..., half:]
    return jnp.concatenate([t1 * cos - t2 * sin, t2 * cos + t1 * sin], axis=-1).astype(t.dtype)


def gated_linear_scan(q, k, v, log_g, strict):
    dtype = v.dtype
    bsz, nh, seq, dk = q.shape
    dv = v.shape[-1]
    n = seq // CHUNK
    q = q.astype(F32).reshape(bsz, nh, n, CHUNK, dk)
    k = k.astype(F32).reshape(bsz, nh, n, CHUNK, dk)
    v = v.astype(F32).reshape(bsz, nh, n, CHUNK, dv)
    lg = log_g.astype(F32)
    lg = lg.reshape(lg.shape[0], nh, n, CHUNK, lg.shape[-1])
    c = jnp.cumsum(lg, axis=3)
    c_last = c[:, :, :, -1:, :]
    q_dec = q * jnp.exp(c)
    k_dec = k * jnp.exp(-c)
    k_end = k * jnp.exp(c_last - c)
    mask = jnp.tril(jnp.ones((CHUNK, CHUNK), dtype=bool), k=-1 if strict else 0)
    scores = jnp.einsum("bhncd,bhnsd->bhncs", q_dec, k_dec)
    o_intra = jnp.einsum("bhncs,bhnsv->bhncv", jnp.where(mask, scores, 0.0), v)
    chunk_decay = jnp.exp(c_last[:, :, :, 0, :])

    def step(state, inp):
        qd, ke, vv, dec = inp
        o = jnp.einsum("bhcd,bhdv->bhcv", qd, state)
        state = dec[..., None] * state + jnp.einsum("bhcd,bhcv->bhdv", ke, vv)
        return state, o

    state0 = jnp.zeros((bsz, nh, dk, dv), F32)
    xs = (jnp.moveaxis(q_dec, 2, 0), jnp.moveaxis(k_end, 2, 0),
          jnp.moveaxis(v, 2, 0), jnp.moveaxis(chunk_decay, 2, 0))
    _, o_inter = lax.scan(step, state0, xs)
    o = o_intra + jnp.moveaxis(o_inter, 0, 2)
    return o.reshape(bsz, nh, seq, dv).astype(dtype)


def bidirectional_scan(q, k, v, log_g_fwd, log_g_bwd):
    fwd = gated_linear_scan(q, k, v, log_g_fwd, strict=False)
    rev = lambda t: jnp.flip(t, axis=2)
    bwd = rev(gated_linear_scan(rev(q), rev(k), rev(v), rev(log_g_bwd), strict=True))
    return fwd + bwd


def retention(u, positions, w_in, decay_logit, w_out):
    seq = u.shape[1]
    qk = RET_HEADS * RET_QK_DIM
    vd = RET_HEADS * RET_V_DIM
    q, k, v, g = jnp.split(u @ w_in, [qk, 2 * qk, 2 * qk + vd], axis=-1)
    q = rotary(split_heads(q, RET_HEADS), positions) * (RET_QK_DIM ** -0.5)
    k = rotary(split_heads(k, RET_HEADS), positions)
    v = split_heads(v, RET_HEADS)
    log_gamma = jax.nn.log_sigmoid(decay_logit.astype(F32))
    lg = lambda d: jnp.broadcast_to(log_gamma[d][None, :, None, None], (1, RET_HEADS, seq, 1))
    o = bidirectional_scan(q, k, v, lg(0), lg(1))
    o = merge_heads(rmsnorm(o)) * jax.nn.silu(g)
    return o @ w_out


def conformer_conv(u, w_in, b_in, w_dw, b_dw, ln_gain, ln_bias, w_out, b_out):
    a, gate = jnp.split(u @ w_in + b_in, 2, axis=-1)
    h = a * jax.nn.sigmoid(gate)
    pad = CONV_WIDTH // 2
    h = lax.conv_general_dilated(
        h, w_dw[:, None, :].astype(h.dtype), window_strides=(1,), padding=[(pad, pad)],
        dimension_numbers=("NWC", "WIO", "NWC"), feature_group_count=D_MODEL) + b_dw
    h = jax.nn.silu(layernorm(h, ln_gain, ln_bias))
    return h @ w_out + b_out


def gla(u, w_in, gate_w1, gate_w2, gate_b, norm_gain, w_out):
    kd = GLA_HEADS * GLA_K_DIM
    vd = GLA_HEADS * GLA_V_DIM
    q, k, v, r = jnp.split(u @ w_in, [kd, 2 * kd, 2 * kd + vd], axis=-1)
    q = split_heads(q, GLA_HEADS) * (GLA_K_DIM ** -0.5)
    k = split_heads(k, GLA_HEADS)
    v = split_heads(v, GLA_HEADS)

    def log_gate(d):
        logits = (u @ gate_w1[d]) @ gate_w2[d] + gate_b[d]
        return split_heads(jax.nn.log_sigmoid(logits.astype(F32)) / GLA_GATE_NORMALIZER, GLA_HEADS)

    o = bidirectional_scan(q, k, v, log_gate(0), log_gate(1))
    o = merge_heads(rmsnorm(o, norm_gain)) * jax.nn.silu(r)
    return o @ w_out


def sq_relu_mlp(u, w_up, w_down):
    return jnp.square(jax.nn.relu(u @ w_up)) @ w_down


def setup_inputs(seed: int = 0) -> dict:
    key = jax.random.key(seed)
    ks = jax.random.split(key, 24)
    nrm = lambda k, shape, scale: jax.random.normal(k, shape, F32) * scale
    x = jax.random.normal(ks[0], (BATCH, SEQ, D_MODEL), F32)
    positions = (jnp.arange(SEQ, dtype=jnp.int32)[None, :]
                 + jax.random.randint(ks[1], (BATCH, 1), 0, SEQ, dtype=jnp.int32))
    norm_gains = 1.0 + nrm(ks[2], (DEPTH, 4, D_MODEL), 0.1)
    ret_w_in = nrm(ks[3], (N_RET, D_MODEL, RET_IN), D_MODEL ** -0.5)
    a = 5.0 + jnp.arange(RET_HEADS, dtype=F32)
    base_logit = jnp.log(2.0 ** a - 1.0)
    ret_decay_logit = base_logit + nrm(ks[4], (N_RET, 2, RET_HEADS), 0.05)
    ret_w_out = nrm(ks[5], (N_RET, RET_HEADS * RET_V_DIM, D_MODEL), (RET_HEADS * RET_V_DIM) ** -0.5)
    conv_w_in = nrm(ks[6], (N_CONV, D_MODEL, 2 * D_MODEL), D_MODEL ** -0.5)
    conv_b_in = nrm(ks[7], (N_CONV, 2 * D_MODEL), 0.02)
    conv_w_dw = nrm(ks[8], (N_CONV, CONV_WIDTH, D_MODEL), CONV_WIDTH ** -0.5)
    conv_b_dw = nrm(ks[9], (N_CONV, D_MODEL), 0.02)
    conv_ln_gain = 1.0 + nrm(ks[10], (N_CONV, D_MODEL), 0.1)
    conv_ln_bias = nrm(ks[11], (N_CONV, D_MODEL), 0.02)
    conv_w_out = nrm(ks[12], (N_CONV, D_MODEL, D_MODEL), D_MODEL ** -0.5)
    conv_b_out = nrm(ks[13], (N_CONV, D_MODEL), 0.02)
    gla_w_in = nrm(ks[14], (N_GLA, D_MODEL, GLA_IN), D_MODEL ** -0.5)
    gla_gate_w1 = nrm(ks[15], (N_GLA, 2, D_MODEL, GLA_GATE_RANK), D_MODEL ** -0.5)
    gla_gate_w2 = nrm(ks[16], (N_GLA, 2, GLA_GATE_RANK, GLA_HEADS * GLA_K_DIM), GLA_GATE_RANK ** -0.5)
    gla_gate_b = nrm(ks[17], (N_GLA, 2, GLA_HEADS * GLA_K_DIM), 0.1)
    gla_norm_gain = 1.0 + nrm(ks[18], (N_GLA, GLA_V_DIM), 0.1)
    gla_w_out = nrm(ks[19], (N_GLA, GLA_HEADS * GLA_V_DIM, D_MODEL), (GLA_HEADS * GLA_V_DIM) ** -0.5)
    mlp_w_up = nrm(ks[20], (DEPTH, D_MODEL, D_FF), D_MODEL ** -0.5)
    mlp_w_down = nrm(ks[21], (DEPTH, D_FF, D_MODEL), D_FF ** -0.5)
    return {
        "x": x, "positions": positions, "norm_gains": norm_gains,
        "ret_w_in": ret_w_in, "ret_decay_logit": ret_decay_logit, "ret_w_out": ret_w_out,
        "conv_w_in": conv_w_in, "conv_b_in": conv_b_in, "conv_w_dw": conv_w_dw,
        "conv_b_dw": conv_b_dw, "conv_ln_gain": conv_ln_gain, "conv_ln_bias": conv_ln_bias,
        "conv_w_out": conv_w_out, "conv_b_out": conv_b_out,
        "gla_w_in": gla_w_in, "gla_gate_w1": gla_gate_w1, "gla_gate_w2": gla_gate_w2,
        "gla_gate_b": gla_gate_b, "gla_norm_gain": gla_norm_gain, "gla_w_out": gla_w_out,
        "mlp_w_up": mlp_w_up, "mlp_w_down": mlp_w_down,
    }


def reference(x, positions, norm_gains, ret_w_in, ret_decay_logit, ret_w_out,
              conv_w_in, conv_b_in, conv_w_dw, conv_b_dw, conv_ln_gain, conv_ln_bias,
              conv_w_out, conv_b_out, gla_w_in, gla_gate_w1, gla_gate_w2, gla_gate_b,
              gla_norm_gain, gla_w_out, mlp_w_up, mlp_w_down):
    h = x
    for i in range(DEPTH):
        kind = i % N_MIXERS
        j = i // N_MIXERS
        u = rmsnorm(h, norm_gains[i, 0])
        if kind == 0:
            y = retention(u, positions, ret_w_in[j], ret_decay_logit[j], ret_w_out[j])
        elif kind == 1:
            y = conformer_conv(u, conv_w_in[j], conv_b_in[j], conv_w_dw[j], conv_b_dw[j],
                               conv_ln_gain[j], conv_ln_bias[j], conv_w_out[j], conv_b_out[j])
        else:
            y = gla(u, gla_w_in[j], gla_gate_w1[j], gla_gate_w2[j], gla_gate_b[j],
                    gla_norm_gain[j], gla_w_out[j])
        h = h + rmsnorm(y, norm_gains[i, 1])
        u = rmsnorm(h, norm_gains[i, 2])
        h = h + rmsnorm(sq_relu_mlp(u, mlp_w_up[i], mlp_w_down[i]), norm_gains[i, 3])
    return h
```

```cpp
#include <hip/hip_runtime.h>
#include <hip/hip_cooperative_groups.h>
#include <cstdio>
#include <cstdint>
namespace cg = cooperative_groups;

#define DI __device__ __forceinline__
typedef unsigned short bf16_t;
typedef short bf16x8 __attribute__((ext_vector_type(8)));
typedef short s16x4 __attribute__((ext_vector_type(4)));
typedef float f32x2 __attribute__((ext_vector_type(2)));
typedef float f32x4 __attribute__((ext_vector_type(4)));
typedef float f32x16 __attribute__((ext_vector_type(16)));
typedef unsigned u32x2 __attribute__((ext_vector_type(2)));
typedef unsigned u32x4 __attribute__((ext_vector_type(4)));
typedef __bf16 bf2_t __attribute__((ext_vector_type(2)));

constexpr int T_ = 32768, L_ = 8192;
constexpr float EPS = 1e-6f;
constexpr size_t MiB = 1u << 20;
constexpr size_t OFF_W = 0, OFF_A = 32 * MiB, OFF_B = 160 * MiB, OFF_C = 288 * MiB, OFF_D = 416 * MiB, OFF_P = 480 * MiB,
                 OFF_RS = 496 * MiB, OFF_E = 497 * MiB, OFF_T1 = 500 * MiB, OFF_BAR = 504 * MiB;
constexpr size_t LDS_BYTES = 163840;

struct Params {
  const float* x; const int* pos; const float* norm_gains;
  const float* ret_w_in; const float* ret_decay; const float* ret_w_out;
  const float* conv_w_in; const float* conv_b_in; const float* conv_w_dw; const float* conv_b_dw; const float* conv_ln_g; const float* conv_ln_b;
  const float* conv_w_out; const float* conv_b_out;
  const float* gla_w_in; const float* gla_w1; const float* gla_w2; const float* gla_gb; const float* gla_ng; const float* gla_w_out;
  const float* mlp_up; const float* mlp_down;
  float* out; char* ws;
};

DI unsigned pk(float lo, float hi) { f32x2 v = {lo, hi}; bf2_t b = __builtin_convertvector(v, bf2_t); return __builtin_bit_cast(unsigned, b); }
DI float bflo(unsigned w) { return __uint_as_float(w << 16); }
DI float bfhi(unsigned w) { return __uint_as_float(w & 0xffff0000u); }
DI float bf1(bf16_t h) { return __uint_as_float(((unsigned)h) << 16); }
DI bf16_t tobf(float f) { return (bf16_t)(pk(f, 0.f) & 0xffffu); }
DI float sigmoidf_(float x) { return 1.0f / (1.0f + __expf(-x)); }
DI const void* karg(int off) {
  const char* kp = (const char*)__builtin_amdgcn_kernarg_segment_ptr();
  const void* r;
  asm volatile("s_load_dwordx2 %0, %1, %2\n\ts_waitcnt lgkmcnt(0)" : "=s"(r) : "s"(kp), "s"(off) : "memory");
  return r;
}
typedef __attribute__((address_space(1))) char gchar_t;
#define KP(f) ((decltype(Params::f))(char*)(gchar_t*)(char*)karg((int)offsetof(Params, f)))
#define GAS __attribute__((address_space(1)))
template <class T> DI T gld(const void* p) { return *(const GAS T*)(const GAS char*)(const char*)p; }
template <class T> DI void gst(void* p, T v) { *(GAS T*)(GAS char*)(char*)p = v; }
DI float log_sigmoid_(float x) {
  const float e = __expf(-fabsf(x));
  const float l1p = (e < 0.0625f) ? e * (1.0f + e * (-0.5f + e * (0.33333334f + e * (-0.25f + e * (0.2f + e * (-0.16666667f + e * 0.14285715f)))))) : __logf(1.0f + e);
  return fminf(x, 0.f) - l1p;
}
DI void lds_barrier() { asm volatile("s_waitcnt lgkmcnt(0)" ::: "memory"); __builtin_amdgcn_s_barrier(); asm volatile("" ::: "memory"); }
DI int obid() { int b = blockIdx.x; asm volatile("" : "+s"(b)); return b; }
DI int otid() { int t = threadIdx.x; asm volatile("" : "+v"(t)); return t; }
DI float wave_sum(float v) {
#pragma unroll
  for (int o = 1; o < 64; o <<= 1) v += __shfl_xor(v, o);
  return v;
}


#define XB_TMO      128
#define XB_XCNT(j)  (256  + 64 * (j))
#define XB_XSUB(j)  (1280 + 64 * (j))
#define XB_XGEN(j)  (2304 + 64 * (j))
#define XB_TOP      3328
#define XB_TOPGEN   3392
#define XCD_BAR_WORDS 3456
#define XB_SPIN_CAP (1u << 18)
#define LAS __attribute__((address_space(3)))
DI unsigned xb_ld(unsigned* p)              { return __hip_atomic_load(p, __ATOMIC_RELAXED, __HIP_MEMORY_SCOPE_AGENT); }
DI unsigned xb_add(unsigned* p, unsigned v) { return __hip_atomic_fetch_add(p, v, __ATOMIC_RELAXED, __HIP_MEMORY_SCOPE_AGENT); }
DI unsigned xb_xcc_id() { return (unsigned)__builtin_amdgcn_s_getreg((3 << 11) | 20) & 0xFu; }
#define XB_SPIN(cond, bar) do { unsigned _sp = 0; while (cond) { __builtin_amdgcn_s_sleep(1); \
    if ((++_sp & 255u) == 0u) { if (xb_ld(&(bar)[XB_TMO])) break; if (_sp > XB_SPIN_CAP) { atomicAdd(&(bar)[XB_TMO], 1u); break; } } } } while (0)
struct XcdBarrier { unsigned* bar; unsigned x; volatile LAS unsigned* st; };
DI XcdBarrier xcd_barrier_post(unsigned* bar, volatile LAS unsigned* st) {
  XcdBarrier b; b.bar = bar; b.x = xb_xcc_id(); b.st = st;
  if (threadIdx.x == 0) (void)xb_add(&bar[XB_XCNT(b.x)], 1u);
  return b;
}
DI void xcd_barrier_complete(unsigned* bar, unsigned x, unsigned& nloc, unsigned& nx) {
  const unsigned G = gridDim.x * gridDim.y * gridDim.z;
  unsigned sum, cnt, mine, sp = 0u;
  for (;;) {
    sum = 0u; cnt = 0u; mine = 0u;
#pragma unroll
    for (unsigned j = 0; j < 16; ++j) { const unsigned c = xb_ld(&bar[XB_XCNT(j)]); sum += c; cnt += (c > 0u) ? 1u : 0u; mine = (j == x) ? c : mine; }
    if (sum == G) break;
    __builtin_amdgcn_s_sleep(1);
    if ((++sp & 255u) == 0u) { if (xb_ld(&bar[XB_TMO])) break; if (sp > XB_SPIN_CAP) { atomicAdd(&bar[XB_TMO], 1u); break; } }
  }
  nloc = mine > 0u ? mine : 1u; nx = cnt > 0u ? cnt : 1u;
}
DI void xcd_barrier(const XcdBarrier& b) {
  asm volatile("s_waitcnt vmcnt(0)" ::: "memory");
  __syncthreads();
  if (threadIdx.x == 0) {
    unsigned* bar = b.bar;
    __builtin_amdgcn_s_waitcnt(0);
    unsigned nloc = b.st[0], nx = b.st[1];
    if (nloc == 0u) { xcd_barrier_complete(bar, b.x, nloc, nx); b.st[0] = nloc; b.st[1] = nx; }
    const unsigned old = xb_add(&bar[XB_XSUB(b.x)], 1u);
    const unsigned gen = old / nloc;
    if (old + 1u == (gen + 1u) * nloc) {
      __builtin_amdgcn_fence(__ATOMIC_RELEASE, "agent");
      asm volatile("s_waitcnt vmcnt(0)" ::: "memory");
      const unsigned og = xb_add(&bar[XB_TOP], 1u);
      const unsigned tg = og / nx;
      if (og + 1u == (tg + 1u) * nx) xb_add(&bar[XB_TOPGEN], 1u);
      else XB_SPIN(xb_ld(&bar[XB_TOPGEN]) == tg, bar);
      __builtin_amdgcn_fence(__ATOMIC_ACQUIRE, "agent");
      xb_add(&bar[XB_XGEN(b.x)], 1u);
      asm volatile("s_waitcnt vmcnt(0)" ::: "memory");
    } else {
      XB_SPIN(xb_ld(&bar[XB_XGEN(b.x)]) == gen, bar);
      __builtin_amdgcn_fence(__ATOMIC_ACQUIRE, "agent");
      asm volatile("s_waitcnt vmcnt(0)" ::: "memory");
    }
  }
  __syncthreads();
}

DI float wsrc(const float* src, int ld, int mode, const float* aux, int k, int n) {
  if (mode == 0) return gld<float>(src + (size_t)k * ld + n);
  if (mode == 1) { int c = ((n >> 7) & 1) * 1024 + (n >> 8) * 128 + (n & 127); return gld<float>(src + (size_t)k * ld + c); }
  if (n < 2048) return gld<float>(src + (size_t)k * ld + n);
  if (n < 2080) { int j = n - 2048; return gld<float>(aux + ((size_t)(j >> 4) * 1024 + k) * 16 + (j & 15)); }
  return 0.f;
}
DI void wconv_job(const float* src, int ld, int K, int Nd, bf16_t* dst, int mode, const float* aux, float* tile, const float* gain) {
  const int tk = K >> 6, tn = Nd >> 6, nt = tk * tn, tid = otid();
  for (int t = blockIdx.x; t < nt; t += gridDim.x) {
    const int k0 = (t % tk) << 6, n0 = (t / tk) << 6;
    __syncthreads();
    if (mode == 0) {
#pragma unroll
      for (int i = 0; i < 2; ++i) {
        const int kk = (tid >> 4) + 32 * i, n4 = (tid & 15) * 4;
        f32x4 v = gld<f32x4>(src + (size_t)(k0 + kk) * ld + n0 + n4);
        if (gain) v = v * gld<float>(gain + k0 + kk);
        tile[kk * 65 + n4] = v[0]; tile[kk * 65 + n4 + 1] = v[1]; tile[kk * 65 + n4 + 2] = v[2]; tile[kk * 65 + n4 + 3] = v[3];
      }
    } else {
#pragma unroll
      for (int i = 0; i < 8; ++i) { int kk = (tid >> 6) + 8 * i, nn = tid & 63; tile[kk * 65 + nn] = wsrc(src, ld, mode, aux, k0 + kk, n0 + nn) * (gain ? gld<float>(gain + k0 + kk) : 1.0f); }
    }
    __syncthreads();
    const int nn = tid >> 3, k8 = (tid & 7) * 8;
    u32x4 w;
    w.x = pk(tile[(k8 + 0) * 65 + nn], tile[(k8 + 1) * 65 + nn]); w.y = pk(tile[(k8 + 2) * 65 + nn], tile[(k8 + 3) * 65 + nn]);
    w.z = pk(tile[(k8 + 4) * 65 + nn], tile[(k8 + 5) * 65 + nn]); w.w = pk(tile[(k8 + 6) * 65 + nn], tile[(k8 + 7) * 65 + nn]);
    gst<u32x4>(dst + (size_t)(n0 + nn) * K + k0 + k8, w);
  }
}
constexpr size_t W_IN = 0;
constexpr size_t W_G = 4096u * 1024u;
constexpr size_t W_OUT = 6144u * 1024u;
constexpr size_t W_UP = 8192u * 1024u;
constexpr size_t W_DN = 12288u * 1024u;
DI void wconv_layer(int layer, float* tile) {
  bf16_t* W = (bf16_t*)(KP(ws) + OFF_W);
  const int kind = layer % 3, j = layer / 3;
  const float* g0 = KP(norm_gains) + layer * 4096;
  const float* g2 = g0 + 2048;
  if (kind == 0) {
    const float* win = KP(ret_w_in) + (size_t)j * 1024 * 6144;
    wconv_job(win, 6144, 1024, 4096, W + W_IN, 0, nullptr, tile, g0);
    wconv_job(win + 4096, 6144, 1024, 2048, W + W_G, 0, nullptr, tile, g0);
    wconv_job(KP(ret_w_out) + (size_t)j * 2048 * 1024, 1024, 2048, 1024, W + W_OUT, 0, nullptr, tile, nullptr);
  } else if (kind == 1) {
    wconv_job(KP(conv_w_in), 2048, 1024, 2048, W + W_IN, 1, nullptr, tile, g0);
    wconv_job(KP(conv_w_out), 1024, 1024, 1024, W + W_OUT, 0, nullptr, tile, nullptr);
  } else {
    wconv_job(KP(gla_w_in), 3072, 1024, 2304, W + W_IN, 2, KP(gla_w1), tile, g0);
    wconv_job(KP(gla_w_in) + 2048, 3072, 1024, 1024, W + W_G, 0, nullptr, tile, g0);
    wconv_job(KP(gla_w_out), 1024, 1024, 1024, W + W_OUT, 0, nullptr, tile, nullptr);
  }
  wconv_job(KP(mlp_up) + (size_t)layer * 1024 * 4096, 4096, 1024, 4096, W + W_UP, 0, nullptr, tile, g2);
  wconv_job(KP(mlp_down) + (size_t)layer * 4096 * 1024, 1024, 4096, 1024, W + W_DN, 0, nullptr, tile, nullptr);
}

DI void rw_phase(const float* x, bf16_t* hb, const bf16_t* y, const float* gpost, float* rh, float* fout) {
  const int tid_ = otid(), wid = tid_ >> 6, lane = tid_ & 63;
  for (int row = blockIdx.x * 8 + wid; row < T_; row += gridDim.x * 8) {
    float hv[16];
    if (x) {
      const float* hp = x + (size_t)row * 1024;
#pragma unroll
      for (int c = 0; c < 2; ++c) {
        const f32x4 a = gld<f32x4>(hp + 512 * c + 8 * lane), b = gld<f32x4>(hp + 512 * c + 8 * lane + 4);
        hv[8 * c + 0] = a[0]; hv[8 * c + 1] = a[1]; hv[8 * c + 2] = a[2]; hv[8 * c + 3] = a[3];
        hv[8 * c + 4] = b[0]; hv[8 * c + 5] = b[1]; hv[8 * c + 6] = b[2]; hv[8 * c + 7] = b[3];
      }
    } else {
#pragma unroll
      for (int c = 0; c < 2; ++c) {
        const u32x4 w = gld<u32x4>(hb + (size_t)row * 1024 + 512 * c + 8 * lane);
        hv[8 * c + 0] = bflo(w.x); hv[8 * c + 1] = bfhi(w.x); hv[8 * c + 2] = bflo(w.y); hv[8 * c + 3] = bfhi(w.y);
        hv[8 * c + 4] = bflo(w.z); hv[8 * c + 5] = bfhi(w.z); hv[8 * c + 6] = bflo(w.w); hv[8 * c + 7] = bfhi(w.w);
      }
    }
    if (y) {
      float yv[16]; float ss = 0.f;
#pragma unroll
      for (int c = 0; c < 2; ++c) {
        const u32x4 w = gld<u32x4>(y + (size_t)row * 1024 + 512 * c + 8 * lane);
        yv[8 * c + 0] = bflo(w.x); yv[8 * c + 1] = bfhi(w.x); yv[8 * c + 2] = bflo(w.y); yv[8 * c + 3] = bfhi(w.y);
        yv[8 * c + 4] = bflo(w.z); yv[8 * c + 5] = bfhi(w.z); yv[8 * c + 6] = bflo(w.w); yv[8 * c + 7] = bfhi(w.w);
      }
#pragma unroll
      for (int i = 0; i < 16; ++i) ss += yv[i] * yv[i];
      ss = wave_sum(ss);
      const float ry = rsqrtf(ss * (1.0f / 1024.0f) + EPS);
#pragma unroll
      for (int c = 0; c < 2; ++c) {
        const f32x4 g0 = gld<f32x4>(gpost + 512 * c + 8 * lane), g1 = gld<f32x4>(gpost + 512 * c + 8 * lane + 4);
#pragma unroll
        for (int i = 0; i < 4; ++i) { hv[8 * c + i] += yv[8 * c + i] * ry * g0[i]; hv[8 * c + 4 + i] += yv[8 * c + 4 + i] * ry * g1[i]; }
      }
    }
    if (fout) {
      float* op = fout + (size_t)row * 1024;
#pragma unroll
      for (int c = 0; c < 2; ++c) {
        gst<f32x4>(op + 512 * c + 8 * lane, (f32x4){hv[8 * c], hv[8 * c + 1], hv[8 * c + 2], hv[8 * c + 3]});
        gst<f32x4>(op + 512 * c + 8 * lane + 4, (f32x4){hv[8 * c + 4], hv[8 * c + 5], hv[8 * c + 6], hv[8 * c + 7]});
      }
    } else {
      float s2 = 0.f;
#pragma unroll
      for (int c = 0; c < 2; ++c) {
        u32x4 w;
        w.x = pk(hv[8 * c + 0], hv[8 * c + 1]); w.y = pk(hv[8 * c + 2], hv[8 * c + 3]); w.z = pk(hv[8 * c + 4], hv[8 * c + 5]); w.w = pk(hv[8 * c + 6], hv[8 * c + 7]);
        gst<u32x4>(hb + (size_t)row * 1024 + 512 * c + 8 * lane, w);
        s2 += bflo(w.x) * bflo(w.x) + bfhi(w.x) * bfhi(w.x) + bflo(w.y) * bflo(w.y) + bfhi(w.y) * bfhi(w.y) +
              bflo(w.z) * bflo(w.z) + bfhi(w.z) * bfhi(w.z) + bflo(w.w) * bflo(w.w) + bfhi(w.w) * bfhi(w.w);
      }
      s2 = wave_sum(s2);
      if (lane == 0) gst<float>(rh + row, rsqrtf(s2 * (1.0f / 1024.0f) + EPS));
    }
  }
}

DI void stats_phase(const bf16_t* o, int HW, float* rs) {
  const int tid_ = otid(), wid = tid_ >> 6, lane = tid_ & 63;
  for (int row = blockIdx.x * 8 + wid; row < T_; row += gridDim.x * 8) {
    if (HW == 2048) {
#pragma unroll
      for (int c = 0; c < 4; ++c) {
        u32x4 w = gld<u32x4>(o + (size_t)row * 2048 + 512 * c + 8 * lane);
        float s = bflo(w.x) * bflo(w.x) + bfhi(w.x) * bfhi(w.x) + bflo(w.y) * bflo(w.y) + bfhi(w.y) * bfhi(w.y) +
                  bflo(w.z) * bflo(w.z) + bfhi(w.z) * bfhi(w.z) + bflo(w.w) * bflo(w.w) + bfhi(w.w) * bfhi(w.w);
        s = wave_sum(s);
        if (lane == 0) gst<float>(rs + row * 4 + c, rsqrtf(s * (1.0f / 512.0f) + EPS));
      }
    } else {
#pragma unroll
      for (int c = 0; c < 2; ++c) {
        u32x4 w = gld<u32x4>(o + (size_t)row * 1024 + 512 * c + 8 * lane);
        float s = bflo(w.x) * bflo(w.x) + bfhi(w.x) * bfhi(w.x) + bflo(w.y) * bflo(w.y) + bfhi(w.y) * bfhi(w.y) +
                  bflo(w.z) * bflo(w.z) + bfhi(w.z) * bfhi(w.z) + bflo(w.w) * bflo(w.w) + bfhi(w.w) * bfhi(w.w);
#pragma unroll
        for (int of = 1; of < 32; of <<= 1) s += __shfl_xor(s, of);
        if ((lane & 31) == 0) gst<float>(rs + row * 4 + 2 * c + (lane >> 5), rsqrtf(s * (1.0f / 256.0f) + EPS));
      }
    }
  }
}

constexpr int BM = 256, BK = 64, HALF = 128, NXCD = 8, WGM = 8, HT = HALF * BK;
enum { EPI_PLAIN = 0, EPI_RELU2 = 1, EPI_RETQKV = 2, EPI_GATE = 3, EPI_GLU = 4, EPI_GLA = 5 };
struct GemmDesc {
  const bf16_t* A; const bf16_t* Bt; int N; int K; int epi; int dvshift;
  bf16_t* o0; bf16_t* o1; float* f0; const float* bias; const float* c0; const int* pos; const float* rowscale;
};
DI int lds_byte(int r, int c) { int st = (r >> 4) * 2 + (c >> 5), rr = r & 15, cc = c & 31, ob = rr * 64 + cc * 2; return st * 1024 + (ob ^ (((ob >> 9) & 1) << 5)); }
DI void stage_rc(int b, int& R, int& C) { int st = b / 1024, sb = b % 1024, swz = sb ^ (((sb >> 9) & 1) << 5); R = (st >> 1) * 16 + swz / 64; C = (st & 1) * 32 + (swz % 64) / 2; }

DI void gemm_epilogue(const GemmDesc& g, f32x4 (&acc)[2][2][4][2], int brow, int bcol, int wr, int wc, int fr, int fq) {
  const int epi = g.epi;
  const int rowb = brow + wr * 64 + fr, colb = bcol + wc * 32 + 8 * fq;
  if (epi == EPI_PLAIN || epi == EPI_RELU2) {
    const int N = g.N;
#pragma unroll
    for (int bj = 0; bj < 2; ++bj) {
      const int col = colb + bj * HALF;
      f32x4 b0 = {0.f, 0.f, 0.f, 0.f}, b1 = b0;
      if (g.bias) { b0 = gld<f32x4>(g.bias + col); b1 = gld<f32x4>(g.bias + col + 4); }
#pragma unroll
      for (int ai = 0; ai < 2; ++ai)
#pragma unroll
        for (int m = 0; m < 4; ++m) {
          const int row = rowb + ai * HALF + m * 16;
          f32x4 v0 = acc[ai][bj][m][0], v1 = acc[ai][bj][m][1];
          if (g.rowscale) { const float ru = gld<float>(g.rowscale + row); v0 = v0 * ru; v1 = v1 * ru; }
          v0 = v0 + b0; v1 = v1 + b1;
          if (epi == EPI_RELU2) {
#pragma unroll
            for (int j = 0; j < 4; ++j) { float r0 = fmaxf(v0[j], 0.f), r1 = fmaxf(v1[j], 0.f); v0[j] = r0 * r0; v1[j] = r1 * r1; }
          }
          u32x4 w; w.x = pk(v0[0], v0[1]); w.y = pk(v0[2], v0[3]); w.z = pk(v1[0], v1[1]); w.w = pk(v1[2], v1[3]);
          gst<u32x4>(g.o0 + (size_t)row * N + col, w);
        }
    }
  } else if (epi == EPI_RETQKV) {
    if (bcol < 2048) {
      const float sc = (bcol < 1024) ? 0.0625f : 1.0f;
      const int d0 = wc * 32 + 8 * fq;
      float fr_[8];
#pragma unroll
      for (int j = 0; j < 8; ++j) fr_[j] = exp2f(-(float)(d0 + j) * (13.287712379549449f / 128.0f)) * 0.15915494309189535f;
#pragma unroll
      for (int ai = 0; ai < 2; ++ai)
#pragma unroll
        for (int m = 0; m < 4; ++m) {
          const int row = rowb + ai * HALF + m * 16;
          const float pf = (float)gld<int>(g.pos + row);
          const float scr = sc * gld<float>(g.rowscale + row);
          float y1[8], y2[8];
#pragma unroll
          for (int n = 0; n < 2; ++n) {
            const f32x4 x1 = acc[ai][0][m][n], x2 = acc[ai][1][m][n];
#pragma unroll
            for (int j = 0; j < 4; ++j) {
              float rev = pf * fr_[4 * n + j]; rev = rev - rintf(rev);
              const float sn = __builtin_amdgcn_sinf(rev), cs = __builtin_amdgcn_cosf(rev);
              y1[4 * n + j] = (x1[j] * cs - x2[j] * sn) * scr; y2[4 * n + j] = (x2[j] * cs + x1[j] * sn) * scr;
            }
          }
          u32x4 w1, w2;
          w1.x = pk(y1[0], y1[1]); w1.y = pk(y1[2], y1[3]); w1.z = pk(y1[4], y1[5]); w1.w = pk(y1[6], y1[7]);
          w2.x = pk(y2[0], y2[1]); w2.y = pk(y2[2], y2[3]); w2.z = pk(y2[4], y2[5]); w2.w = pk(y2[6], y2[7]);
          bf16_t* op = g.o0 + (size_t)row * 2048 + bcol + d0;
          gst<u32x4>(op, w1); gst<u32x4>(op + 128, w2);
        }
    } else {
#pragma unroll
      for (int bj = 0; bj < 2; ++bj) {
        const int col = colb - 2048 + bj * HALF;
#pragma unroll
        for (int ai = 0; ai < 2; ++ai)
#pragma unroll
          for (int m = 0; m < 4; ++m) {
            const int row = rowb + ai * HALF + m * 16;
            const float ru = gld<float>(g.rowscale + row);
            const f32x4 v0 = acc[ai][bj][m][0] * ru, v1 = acc[ai][bj][m][1] * ru;
            u32x4 w; w.x = pk(v0[0], v0[1]); w.y = pk(v0[2], v0[3]); w.z = pk(v1[0], v1[1]); w.w = pk(v1[2], v1[3]);
            gst<u32x4>(g.o1 + (size_t)row * 2048 + col, w);
          }
      }
    }
  } else if (epi == EPI_GATE) {
    const int N = g.N, dvm = (1 << g.dvshift) - 1;
#pragma unroll
    for (int bj = 0; bj < 2; ++bj) {
      const int col = colb + bj * HALF;
      f32x4 g0 = {1.f, 1.f, 1.f, 1.f}, g1 = g0;
      if (g.c0) { g0 = gld<f32x4>(g.c0 + (col & dvm)); g1 = gld<f32x4>(g.c0 + (col & dvm) + 4); }
      const int head = col >> g.dvshift;
#pragma unroll
      for (int ai = 0; ai < 2; ++ai)
#pragma unroll
        for (int m = 0; m < 4; ++m) {
          const int row = rowb + ai * HALF + m * 16;
          float rs;
          { const float* sp = g.f0 + (size_t)row * 32 + head * 8;
            const f32x4 s0 = gld<f32x4>(sp); float ssum = (s0[0] + s0[1]) + (s0[2] + s0[3]);
            if (g.dvshift == 9) { const f32x4 s1 = gld<f32x4>(sp + 4); ssum += (s1[0] + s1[1]) + (s1[2] + s1[3]); }
            rs = rsqrtf(ssum * (g.dvshift == 9 ? (1.0f / 512.0f) : (1.0f / 256.0f)) + EPS); }
          bf16_t* op = g.o0 + (size_t)row * N + col;
          const u32x4 ow = gld<u32x4>(op);
          const float ru = gld<float>(g.rowscale + row);
          const f32x4 v0 = acc[ai][bj][m][0] * ru, v1 = acc[ai][bj][m][1] * ru;
          float o[8] = {bflo(ow.x), bfhi(ow.x), bflo(ow.y), bfhi(ow.y), bflo(ow.z), bfhi(ow.z), bflo(ow.w), bfhi(ow.w)};
#pragma unroll
          for (int j = 0; j < 4; ++j) { o[j] = o[j] * rs * g0[j] * v0[j] * sigmoidf_(v0[j]); o[4 + j] = o[4 + j] * rs * g1[j] * v1[j] * sigmoidf_(v1[j]); }
          u32x4 w; w.x = pk(o[0], o[1]); w.y = pk(o[2], o[3]); w.z = pk(o[4], o[5]); w.w = pk(o[6], o[7]);
          gst<u32x4>(op, w);
        }
    }
  } else if (epi == EPI_GLU) {
    const int ca = 128 * (bcol >> 8) + wc * 32 + 8 * fq;
    const f32x4 ba0 = gld<f32x4>(g.bias + ca), ba1 = gld<f32x4>(g.bias + ca + 4);
    const f32x4 bg0 = gld<f32x4>(g.bias + 1024 + ca), bg1 = gld<f32x4>(g.bias + 1024 + ca + 4);
#pragma unroll
    for (int ai = 0; ai < 2; ++ai)
#pragma unroll
      for (int m = 0; m < 4; ++m) {
        const int row = rowb + ai * HALF + m * 16;
        const float ru = gld<float>(g.rowscale + row);
        const f32x4 a0 = acc[ai][0][m][0] * ru + ba0, a1 = acc[ai][0][m][1] * ru + ba1, t0 = acc[ai][1][m][0] * ru + bg0, t1 = acc[ai][1][m][1] * ru + bg1;
        float o[8];
#pragma unroll
        for (int j = 0; j < 4; ++j) { o[j] = a0[j] * sigmoidf_(t0[j]); o[4 + j] = a1[j] * sigmoidf_(t1[j]); }
        u32x4 w; w.x = pk(o[0], o[1]); w.y = pk(o[2], o[3]); w.z = pk(o[4], o[5]); w.w = pk(o[6], o[7]);
        gst<u32x4>(g.o0 + (size_t)row * 1024 + ca, w);
      }
  } else {
#pragma unroll
    for (int bj = 0; bj < 2; ++bj) {
      const int col = colb + bj * HALF;
#pragma unroll
      for (int ai = 0; ai < 2; ++ai)
#pragma unroll
        for (int m = 0; m < 4; ++m) {
          const int row = rowb + ai * HALF + m * 16;
          const float ru = gld<float>(g.rowscale + row);
          f32x4 v0 = acc[ai][bj][m][0] * ru, v1 = acc[ai][bj][m][1] * ru;
          if (bcol < 2048) {
            if (bcol < 512) { v0 = v0 * 0.08838834764831845f; v1 = v1 * 0.08838834764831845f; }
            bf16_t* base = (bcol < 1024) ? (g.o0 + (size_t)row * 1024 + col) : (g.o1 + (size_t)row * 1024 + (col - 1024));
            u32x4 w; w.x = pk(v0[0], v0[1]); w.y = pk(v0[2], v0[3]); w.z = pk(v1[0], v1[1]); w.w = pk(v1[2], v1[3]);
            gst<u32x4>(base, w);
          } else if (col < 2080) {
            gst<f32x4>(g.f0 + (size_t)row * 32 + (col - 2048), v0); gst<f32x4>(g.f0 + (size_t)row * 32 + (col - 2048) + 4, v1);
          }
        }
    }
  }
}

DI int perm32(int rho) { const int n = rho >> 4, i = rho & 15; return 8 * (i >> 2) + 4 * n + (i & 3); }
DI bool tile_next(int i, int G, int c, int nM, int nN, int& pm, int& pn) {
  const int nwg = nM * nN; const long L = (long)i * G + c; if (L >= nwg) return false;
  int wgid = (int)L; { const int q = nwg / NXCD, r = nwg % NXCD, xcd = wgid % NXCD, off = wgid / NXCD; wgid = (xcd < r ? xcd * (q + 1) : r * (q + 1) + (xcd - r) * q) + off; }
  const int nig = WGM * nN, gid = wgid / nig, fm = gid * WGM, gsz = (nM - fm) < WGM ? (nM - fm) : WGM;
  pm = fm + ((wgid % nig) % gsz); pn = (wgid % nig) / gsz; return true;
}
DI void gemm_phase(const GemmDesc& g, LAS unsigned char* lds) {
  constexpr int HTB = HALF * BK * 2;
  const int tid = otid(), wid = __builtin_amdgcn_readfirstlane(tid >> 6), lane = tid & 63, wr = wid >> 2, wc = wid & 3, fr = lane & 15, fq = lane >> 4;
  const int K = g.K, nt = K / BK, nM = T_ / BM, nN = g.N / BM, G = gridDim.x, cb = blockIdx.x;
  unsigned voffA[2], voffB[2];
#pragma unroll
  for (int i = 0; i < 2; ++i) { int R, C; stage_rc(tid * 16 + i * 8192, R, C); const int Rb = (R & ~31) + perm32(R & 31);
    voffA[i] = (unsigned)(R * K + C) * 2u; voffB[i] = (unsigned)(Rb * K + C) * 2u; }
  const size_t kstep = (size_t)(BK * 2), hstep = (size_t)HALF * K * 2, tstep = 2 * hstep;
  const unsigned ldsw = (unsigned)wid * 1024u;
  const int aoff = lds_byte(wr * 64 + fr, fq * 8), boff = lds_byte(wc * 32 + fr, fq * 8);
#define PG8_SA(b, h) (((b) * 2 + (h)) * HTB)
#define PG8_SB(b, h) ((4 + (b) * 2 + (h)) * HTB)
#define PG8_STAGE(bufoff, gbase, voff) do { _Pragma("unroll") for (int _i = 0; _i < 2; ++_i) \
    __builtin_amdgcn_global_load_lds((const unsigned*)((const char*)(gbase) + (voff)[_i]), (LAS unsigned*)(lds + (bufoff) + ldsw + _i * 8192), 16, 0, 0); } while (0)
#define PG8_LDA(dst, b, h) do { _Pragma("unroll") for (int m = 0; m < 4; ++m) _Pragma("unroll") for (int k = 0; k < 2; ++k) dst[m][k] = *(const LAS bf16x8*)(lds + PG8_SA(b, h) + aoff + m * 2048 + k * 1024); } while (0)
#define PG8_LDB(dst, b, h) do { _Pragma("unroll") for (int n = 0; n < 2; ++n) _Pragma("unroll") for (int k = 0; k < 2; ++k) dst[n][k] = *(const LAS bf16x8*)(lds + PG8_SB(b, h) + boff + n * 2048 + k * 1024); } while (0)
#define PG8_MMA(ai, bj, At, Bt) do { __builtin_amdgcn_s_setprio(1); _Pragma("unroll") for (int m = 0; m < 4; ++m) _Pragma("unroll") for (int n = 0; n < 2; ++n) _Pragma("unroll") for (int k = 0; k < 2; ++k) \
    acc[ai][bj][m][n] = __builtin_amdgcn_mfma_f32_16x16x32_bf16(Bt[n][k], At[m][k], acc[ai][bj][m][n], 0, 0, 0); __builtin_amdgcn_s_setprio(0); } while (0)
#define PG8_WAIT_V(n) asm volatile("s_waitcnt vmcnt(" #n ")" ::: "memory")
#define PG8_WAIT_L(n) asm volatile("s_waitcnt lgkmcnt(" #n ")" ::: "memory")
#define PG8_BAR __builtin_amdgcn_s_barrier()
#define PG8_SCHED __builtin_amdgcn_sched_barrier(0)
  int cpm, cpn, npm = 0, npn = 0, ui = 0;
  if (!tile_next(0, G, cb, nM, nN, cpm, cpn)) return;
  f32x4 acc[2][2][4][2];
#pragma unroll
  for (int a = 0; a < 2; ++a)
#pragma unroll
    for (int b = 0; b < 2; ++b)
#pragma unroll
      for (int m = 0; m < 4; ++m)
#pragma unroll
        for (int n = 0; n < 2; ++n) acc[a][b][m][n] = (f32x4){0.f, 0.f, 0.f, 0.f};
  bf16x8 At[4][2], B0[2][2], B1[2][2];
  const char* cA = (const char*)g.A + (size_t)cpm * tstep; const char* cB = (const char*)g.Bt + (size_t)cpn * tstep;
  PG8_STAGE(PG8_SB(0, 0), cB, voffB); PG8_STAGE(PG8_SB(0, 1), cB + hstep, voffB); PG8_STAGE(PG8_SA(0, 0), cA, voffA); PG8_STAGE(PG8_SA(0, 1), cA + hstep, voffA);
  if (wr == 1) PG8_BAR;
  PG8_WAIT_V(2); PG8_BAR;
  PG8_STAGE(PG8_SB(1, 0), cB + kstep, voffB); PG8_STAGE(PG8_SA(1, 0), cA + kstep, voffA); PG8_STAGE(PG8_SB(1, 1), cB + hstep + kstep, voffB);
  PG8_WAIT_V(6); PG8_BAR;
  for (;;) {
    const bool has_next = tile_next(ui + 1, G, cb, nM, nN, npm, npn);
    const char* nA = has_next ? (const char*)g.A + (size_t)npm * tstep : cA; const char* nB = has_next ? (const char*)g.Bt + (size_t)npn * tstep : cB;
    for (int t = 0; t < nt; t += 2) {
      const bool last = (t == nt - 2);
      const char* a1 = cA + (size_t)(t + 1) * kstep;
      const char* a2 = last ? nA : cA + (size_t)(t + 2) * kstep; const char* b2 = last ? nB : cB + (size_t)(t + 2) * kstep;
      const char* a3 = a2 + kstep; const char* b3 = b2 + kstep;
      PG8_LDB(B0, 0, 0); PG8_LDB(B1, 0, 1); PG8_SCHED; PG8_LDA(At, 0, 0); PG8_STAGE(PG8_SA(1, 1), a1 + hstep, voffA);
      PG8_WAIT_V(8); PG8_WAIT_L(0); PG8_BAR; PG8_MMA(0, 0, At, B0); PG8_MMA(0, 1, At, B1); PG8_BAR; PG8_SCHED;
      PG8_LDA(At, 0, 1); PG8_STAGE(PG8_SB(0, 0), b2, voffB); PG8_STAGE(PG8_SB(0, 1), b2 + hstep, voffB); PG8_STAGE(PG8_SA(0, 0), a2, voffA);
      PG8_WAIT_V(8); PG8_WAIT_L(0); PG8_BAR; PG8_MMA(1, 0, At, B0); PG8_MMA(1, 1, At, B1); PG8_BAR; PG8_SCHED;
      PG8_LDB(B0, 1, 0); PG8_LDB(B1, 1, 1); PG8_SCHED; PG8_LDA(At, 1, 0); PG8_STAGE(PG8_SA(0, 1), a2 + hstep, voffA);
      PG8_WAIT_V(8); PG8_WAIT_L(0); PG8_BAR; PG8_MMA(0, 0, At, B0); PG8_MMA(0, 1, At, B1); PG8_BAR; PG8_SCHED;
      PG8_LDA(At, 1, 1); PG8_STAGE(PG8_SB(1, 0), b3, voffB); PG8_STAGE(PG8_SB(1, 1), b3 + hstep, voffB); PG8_STAGE(PG8_SA(1, 0), a3, voffA);
      PG8_WAIT_V(8); PG8_WAIT_L(0); PG8_BAR; PG8_MMA(1, 0, At, B0); PG8_MMA(1, 1, At, B1); PG8_BAR; PG8_SCHED;
    }
    if (wr == 0) PG8_BAR;
    gemm_epilogue(g, acc, cpm * BM, cpn * BM, wr, wc, fr, fq);
    if (!has_next) break;
#pragma unroll
    for (int a = 0; a < 2; ++a)
#pragma unroll
      for (int b = 0; b < 2; ++b)
#pragma unroll
        for (int m = 0; m < 4; ++m)
#pragma unroll
          for (int n = 0; n < 2; ++n) acc[a][b][m][n] = (f32x4){0.f, 0.f, 0.f, 0.f};
    cpm = npm; cpn = npn; cA = nA; cB = nB; ++ui;
    if (wr == 1) PG8_BAR;
  }
  PG8_WAIT_V(0);
  PG8_BAR;
}

template <int R> DI void conv_row(f32x2 (&acc)[32], const f32x2 (&wt)[31], const unsigned* tile, int tid) {
  const unsigned x = tile[R * 512 + tid];
  const f32x2 xv = {bflo(x), bfhi(x)};
#pragma unroll
  for (int i = 0; i < 32; ++i) { if (R - i >= 0 && R - i < 31) acc[i] = acc[i] + xv * wt[(R - i >= 0 && R - i < 31) ? R - i : 0]; }
  if ((R & 7) == 7) asm volatile("" ::: "memory");
}
template <int R0, int N> struct ConvRows {
  static DI void run(f32x2 (&acc)[32], const f32x2 (&wt)[31], const unsigned* tile, int tid) { conv_row<R0>(acc, wt, tile, tid); ConvRows<R0 + 1, N - 1>::run(acc, wt, tile, tid); }
};
template <int R0> struct ConvRows<R0, 0> { static DI void run(f32x2 (&)[32], const f32x2 (&)[31], const unsigned*, int) {} };
DI void conv_phase(const bf16_t* hc, bf16_t* hn, char* lds) {
  const float* wdw = KP(conv_w_dw);
  const int tid = otid();
  unsigned* tile = (unsigned*)lds;
  float* red = (float*)lds;
  unsigned toff = 131072; asm volatile("" : "+s"(toff));
  float* tot = (float*)(lds + toff);
  const f32x2 bdw = gld<f32x2>(KP(conv_b_dw) + 2 * tid);
  const f32x2 lg = gld<f32x2>(KP(conv_ln_g) + 2 * tid), lb = gld<f32x2>(KP(conv_ln_b) + 2 * tid);
  for (int item = blockIdx.x; item < T_ / 32; item += gridDim.x) {
    const int b = item >> 8, t0 = (item & 255) * 32;
    __syncthreads();
#pragma unroll
    for (int hf = 0; hf < 2; ++hf) {
      u32x4 w[8];
#pragma unroll
      for (int i = 0; i < 8; ++i) {
        const int c = tid + 512 * (8 * hf + i), r = c >> 7, ch = c & 127, t = t0 - 15 + r;
        w[i] = (u32x4){0u, 0u, 0u, 0u};
        if (r < 62 && t >= 0 && t < L_) w[i] = gld<u32x4>(hc + ((size_t)(b * L_ + t)) * 1024 + ch * 8);
      }
#pragma unroll
      for (int i = 0; i < 8; ++i) {
        const int c = tid + 512 * (8 * hf + i), r = c >> 7, ch = c & 127;
        if (r < 62) *(u32x4*)(tile + r * 512 + ch * 4) = w[i];
      }
      asm volatile("" ::: "memory");
    }
    __syncthreads();
    const float* wd2 = wdw; asm volatile("" : "+s"(wd2));
    f32x2 acc[32], wt[31];
#pragma unroll
    for (int i = 0; i < 32; ++i) acc[i] = bdw;
#pragma unroll
    for (int j = 0; j < 31; ++j) wt[j] = gld<f32x2>(wd2 + j * 1024 + 2 * tid);
    ConvRows<0, 62>::run(acc, wt, tile, tid);
    __syncthreads();
#pragma unroll
    for (int i = 0; i < 32; ++i) { red[i * 512 + tid] = acc[i].x + acc[i].y; red[(32 + i) * 512 + tid] = acc[i].x * acc[i].x + acc[i].y * acc[i].y; }
    __syncthreads();
    {
      const int q = tid >> 3, part = tid & 7;
      float sm = 0.f;
#pragma unroll
      for (int i = 0; i < 16; ++i) { f32x4 v = *(const f32x4*)(red + q * 512 + part * 64 + i * 4); sm += (v[0] + v[1]) + (v[2] + v[3]); }
      sm += __shfl_xor(sm, 1); sm += __shfl_xor(sm, 2); sm += __shfl_xor(sm, 4);
      if (part == 0) tot[q] = sm;
    }
    __syncthreads();
#pragma unroll
    for (int i = 0; i < 32; ++i) {
      const float mu = tot[i] * (1.0f / 1024.0f), var = fmaxf(tot[32 + i] * (1.0f / 1024.0f) - mu * mu, 0.f), rstd = rsqrtf(var + EPS);
      float y0 = (acc[i].x - mu) * rstd * lg.x + lb.x, y1 = (acc[i].y - mu) * rstd * lg.y + lb.y;
      y0 = y0 * sigmoidf_(y0); y1 = y1 * sigmoidf_(y1);
      gst<unsigned>(hn + ((size_t)(b * L_ + t0 + i)) * 1024 + 2 * tid, pk(y0, y1));
    }
  }
}

DI void glaprep_phase(const bf16_t* qk, const float* t1, bf16_t* QKf, bf16_t* QKb, float* E, char* lds) {
  const int tid = otid();
  float* t1s = (float*)lds;
  bf16_t* raw = (bf16_t*)(lds + 8192);
  float w2f[16], w2b[16];
  const float* gw2 = KP(gla_w2); const float* ggb = KP(gla_gb);
#pragma unroll
  for (int r = 0; r < 16; ++r) { w2f[r] = gld<float>(gw2 + r * 512 + tid); w2b[r] = gld<float>(gw2 + (16 + r) * 512 + tid); }
  const float bf_ = gld<float>(ggb + tid), bb_ = gld<float>(ggb + 512 + tid);
  for (int item = blockIdx.x; item < T_ / 64; item += gridDim.x) {
    const size_t tok0 = (size_t)item * 64;
    __syncthreads();
    {
      u32x4 w[16];
#pragma unroll
      for (int i = 0; i < 16; ++i) w[i] = gld<u32x4>(qk + tok0 * 1024 + (size_t)(tid + 512 * i) * 8);
      const f32x4 tv = gld<f32x4>(t1 + tok0 * 32 + tid * 4);
#pragma unroll
      for (int i = 0; i < 16; ++i) *(u32x4*)(raw + (size_t)(tid + 512 * i) * 8) = w[i];
      *(f32x4*)(t1s + tid * 4) = tv;
    }
    __syncthreads();
    float c = 0.f;
#pragma unroll 8
    for (int i = 0; i < 64; ++i) {
      float lgt = bf_;
#pragma unroll
      for (int r = 0; r < 16; ++r) lgt += t1s[i * 32 + r] * w2f[r];
      c += log_sigmoid_(lgt) * (1.0f / 16.0f);
      const float qv = bf1(raw[i * 1024 + tid]), kv = bf1(raw[i * 1024 + 512 + tid]);
      gst<bf16_t>(QKf + (tok0 + i) * 1024 + tid, tobf(qv * __expf(c)));
      gst<bf16_t>(QKf + (tok0 + i) * 1024 + 512 + tid, tobf(kv * __expf(-c)));
    }
    gst<float>(E + (size_t)item * 512 + tid, __expf(c));
    c = 0.f;
#pragma unroll 8
    for (int i = 63; i >= 0; --i) {
      float lgt = bb_;
#pragma unroll
      for (int r = 0; r < 16; ++r) lgt += t1s[i * 32 + 16 + r] * w2b[r];
      c += log_sigmoid_(lgt) * (1.0f / 16.0f);
      const float qv = bf1(raw[i * 1024 + tid]), kv = bf1(raw[i * 1024 + 512 + tid]);
      gst<bf16_t>(QKb + (tok0 + i) * 1024 + tid, tobf(qv * __expf(c)));
      gst<bf16_t>(QKb + (tok0 + i) * 1024 + 512 + tid, tobf(kv * __expf(-c)));
    }
    gst<float>(E + (size_t)(T_ / 64) * 512 + (size_t)item * 512 + tid, __expf(c));
  }
}

template <int DK, bool GLA>
DI void ppass_phase(const bf16_t* Qf, const bf16_t* Kf, const bf16_t* Qb, const bf16_t* Kb, int ld, const float* decay, bf16_t* P) {
  const int tid_ = otid(), wid = tid_ >> 6, lane = tid_ & 63, fr = lane & 15, fq = lane >> 4;
  const int rt = wid >> 1, ct0 = 2 * (wid & 1);
  for (int item = blockIdx.x; item < 2048; item += gridDim.x) {
    const int n = item & 127, h = (item >> 7) & 3, b = item >> 9;
    const size_t tok0 = (size_t)b * L_ + n * 64;
    f32x4 xf[2] = {}, xb[2] = {};
    const bf16_t* qa = Qf + (tok0 + 16 * rt + fr) * ld + h * DK + 8 * fq;
    const bf16_t* ka0 = Kf + (tok0 + 16 * ct0 + fr) * ld + h * DK + 8 * fq;
    const bf16_t* ka1 = ka0 + (size_t)16 * ld;
#pragma unroll
    for (int kk = 0; kk < DK / 32; ++kk) {
      const bf16x8 a = gld<bf16x8>(qa + 32 * kk), b0 = gld<bf16x8>(ka0 + 32 * kk), b1 = gld<bf16x8>(ka1 + 32 * kk);
      xf[0] = __builtin_amdgcn_mfma_f32_16x16x32_bf16(a, b0, xf[0], 0, 0, 0);
      xf[1] = __builtin_amdgcn_mfma_f32_16x16x32_bf16(a, b1, xf[1], 0, 0, 0);
    }
    if (GLA) {
      const bf16_t* qb = Qb + (tok0 + 16 * rt + fr) * ld + h * DK + 8 * fq;
      const bf16_t* kb0 = Kb + (tok0 + 16 * ct0 + fr) * ld + h * DK + 8 * fq;
      const bf16_t* kb1 = kb0 + (size_t)16 * ld;
#pragma unroll
      for (int kk = 0; kk < DK / 32; ++kk) {
        const bf16x8 a = gld<bf16x8>(qb + 32 * kk), b0 = gld<bf16x8>(kb0 + 32 * kk), b1 = gld<bf16x8>(kb1 + 32 * kk);
        xb[0] = __builtin_amdgcn_mfma_f32_16x16x32_bf16(a, b0, xb[0], 0, 0, 0);
        xb[1] = __builtin_amdgcn_mfma_f32_16x16x32_bf16(a, b1, xb[1], 0, 0, 0);
      }
    }
    bf16_t* Po = P + (size_t)item * 4096;
    Po = P + ((size_t)((b * 128 + n) * 4 + h)) * 4096;
#pragma unroll
    for (int c = 0; c < 2; ++c)
#pragma unroll
      for (int j = 0; j < 4; ++j) {
        const int i = 16 * rt + 4 * fq + j, s = 16 * (ct0 + c) + fr;
        float v;
        if (GLA) v = (s <= i) ? xf[c][j] : xb[c][j];
        else v = xf[c][j];
        gst<bf16_t>(Po + i * 64 + s, tobf(v));
      }
  }
}

struct FalseC { static constexpr bool value = false; }; struct TrueC { static constexpr bool value = true; };
struct ScanArgs {
  const bf16_t* q0; const bf16_t* q1; const bf16_t* k0; const bf16_t* k1;
  const bf16_t* v; const bf16_t* P; bf16_t* o;
  const float* E;
  const float* decay;
  float* ssp;
};
DI s16x4 tr_read(unsigned a) { s16x4 r; asm volatile("ds_read_b64_tr_b16 %0, %1\n\ts_waitcnt lgkmcnt(0)" : "=&v"(r) : "v"(a) : "memory"); return r; }
template <int SA_, int SB_>
DI void tr_read8(unsigned a, s16x4 (&r)[8]) {
  asm volatile("ds_read_b64_tr_b16 %0, %8 offset:%9\n\tds_read_b64_tr_b16 %1, %8 offset:%10\n\tds_read_b64_tr_b16 %2, %8 offset:%11\n\tds_read_b64_tr_b16 %3, %8 offset:%12\n\t"
               "ds_read_b64_tr_b16 %4, %8 offset:%13\n\tds_read_b64_tr_b16 %5, %8 offset:%14\n\tds_read_b64_tr_b16 %6, %8 offset:%15\n\tds_read_b64_tr_b16 %7, %8 offset:%16\n\t"
               "s_waitcnt lgkmcnt(0)"
               : "=&v"(r[0]), "=&v"(r[1]), "=&v"(r[2]), "=&v"(r[3]), "=&v"(r[4]), "=&v"(r[5]), "=&v"(r[6]), "=&v"(r[7])
               : "v"(a), "n"(0), "n"(SA_), "n"(SB_), "n"(SB_ + SA_), "n"(2 * SB_), "n"(2 * SB_ + SA_), "n"(3 * SB_), "n"(3 * SB_ + SA_)
               : "memory");
}
template <int SA_, int SB_>
DI void tr_issue8(unsigned a, s16x4 (&r)[8]) {
  asm volatile("ds_read_b64_tr_b16 %0, %8 offset:%9\n\tds_read_b64_tr_b16 %1, %8 offset:%10\n\tds_read_b64_tr_b16 %2, %8 offset:%11\n\tds_read_b64_tr_b16 %3, %8 offset:%12\n\t"
               "ds_read_b64_tr_b16 %4, %8 offset:%13\n\tds_read_b64_tr_b16 %5, %8 offset:%14\n\tds_read_b64_tr_b16 %6, %8 offset:%15\n\tds_read_b64_tr_b16 %7, %8 offset:%16"
               : "=&v"(r[0]), "=&v"(r[1]), "=&v"(r[2]), "=&v"(r[3]), "=&v"(r[4]), "=&v"(r[5]), "=&v"(r[6]), "=&v"(r[7])
               : "v"(a), "n"(0), "n"(SA_), "n"(SB_), "n"(SB_ + SA_), "n"(2 * SB_), "n"(2 * SB_ + SA_), "n"(3 * SB_), "n"(3 * SB_ + SA_)
               : "memory");
}
DI void tr_wait8(s16x4 (&a)[8]) {
  asm volatile("s_waitcnt lgkmcnt(0)" : "+v"(a[0]), "+v"(a[1]), "+v"(a[2]), "+v"(a[3]), "+v"(a[4]), "+v"(a[5]), "+v"(a[6]), "+v"(a[7]) :: "memory");
}
DI void tr_wait16(s16x4 (&a)[8], s16x4 (&b)[8]) {
  asm volatile("s_waitcnt lgkmcnt(0)" : "+v"(a[0]), "+v"(a[1]), "+v"(a[2]), "+v"(a[3]), "+v"(a[4]), "+v"(a[5]), "+v"(a[6]), "+v"(a[7]),
               "+v"(b[0]), "+v"(b[1]), "+v"(b[2]), "+v"(b[3]), "+v"(b[4]), "+v"(b[5]), "+v"(b[6]), "+v"(b[7]) :: "memory");
}
DI bf16x8 cat8(s16x4 a, s16x4 b) { bf16x8 r; r[0] = a[0]; r[1] = a[1]; r[2] = a[2]; r[3] = a[3]; r[4] = b[0]; r[5] = b[1]; r[6] = b[2]; r[7] = b[3]; return r; }
DI u32x4 scale8(u32x4 w, float s) {
  u32x4 r; r.x = pk(bflo(w.x) * s, bfhi(w.x) * s); r.y = pk(bflo(w.y) * s, bfhi(w.y) * s); r.z = pk(bflo(w.z) * s, bfhi(w.z) * s); r.w = pk(bflo(w.w) * s, bfhi(w.w) * s); return r;
}
template <int DK>
DI void scan_phase(const ScanArgs& a, char* lds, const XcdBarrier& xb) {
  constexpr int QS = DK * 2 + 16, KS = DK * 2 + 64, VS = 192, PS = 144, NQ = DK / 128 * 2;
  constexpr int RW = DK / 4, NT = RW / 32;
  constexpr int LDQK = (DK == 256) ? 2048 : 1024, LDV = LDQK, LDO = LDQK, DVH = 2 * DK;
  constexpr bool ret = (DK == 256);
  constexpr int OFF_K = 64 * QS, OFF_V = OFF_K + 64 * KS, OFF_PP = OFF_V + 64 * VS, OFF_O = OFF_PP + 64 * PS, OFF_EE = OFF_O + 65536, OFF_SC = OFF_EE + DK * 4;
  static_assert(OFF_SC + 512 <= (int)LDS_BYTES - 16, "LDS budget");
  const int tid = otid(), wid = tid >> 6, lane = tid & 63, wr = __builtin_amdgcn_readfirstlane(wid >> 1), wc = __builtin_amdgcn_readfirstlane(wid & 1);
  const int r = lane & 31, hh = lane >> 5, g1 = (lane >> 4) & 1, i16 = lane & 15, qd = i16 >> 2, pp = i16 & 3;
  const unsigned ldsb = (unsigned)(uintptr_t)lds;
  float* qsc = (float*)(lds + OFF_SC); float* ksc = qsc + 64;
  constexpr int NS = DVH >> 6, nitems = 32 * NS;
  const int bid = obid(), xcd = bid & 7, inx = bid >> 3;
  const bool g256 = (gridDim.x == 256);
  const bool active = g256 ? (inx < 4 * NS) : (bid < nitems);
  const int item = g256 ? ((xcd * 4 + inx / NS) * NS + inx % NS) : bid;
  const int slice = item % NS, dir = (item / NS) & 1, h = (item / (2 * NS)) & 3, b = item / (8 * NS);
  float econst = 1.f;
  if (active && ret) {
    const float lg = log_sigmoid_(gld<float>(a.decay + dir * 4 + h));
    econst = __expf(64.f * lg);
    if (tid < 64) { const float e = dir ? (float)(64 - tid) : (float)(tid + 1); qsc[tid] = __expf(lg * e); ksc[tid] = __expf(-lg * e); }
  }
  __syncthreads();
  const bf16_t* qg = (dir ? a.q1 : a.q0) + (size_t)b * L_ * LDQK + h * DK;
  const bf16_t* kg = (dir ? a.k1 : a.k0) + (size_t)b * L_ * LDQK + h * DK;
  const bf16_t* vg = a.v + (size_t)b * L_ * LDV + h * DVH + slice * 64;
  bf16_t* og = a.o + (size_t)b * L_ * LDO + h * DVH + slice * 64;
  const bf16_t* pg = a.P + ((size_t)(b * 128) * 4 + h) * 4096;
  const float* eg = ret ? nullptr : (a.E + (size_t)dir * (T_ / 64) * (4 * DK) + (size_t)(b * 128) * (4 * DK) + h * DK);
  f32x16 S[NT];
#pragma unroll
  for (int j = 0; j < NT; ++j)
#pragma unroll
    for (int e = 0; e < 16; ++e) S[j][e] = 0.f;
  struct Regs { u32x4 q[NQ], k[NQ], v, p; };
  Regs RA, RB;
  constexpr int DEPTH = (DK == 128) ? 2 : 1;
  float enext = 1.f;
  const int vrow = tid >> 3, vch = tid & 7;
  auto chunk_of = [&](int st) { const int s2 = st < 128 ? st : 127; return dir ? 127 - s2 : s2; };
  auto issue = [&](Regs& R, int n) {
    const size_t t0 = (size_t)n * 64;
#pragma unroll
    for (int i = 0; i < NQ; ++i) {
      const int c = tid + 512 * i, row = c / (DK / 8), ch = c % (DK / 8);
      R.q[i] = gld<u32x4>(qg + (t0 + row) * LDQK + ch * 8);
      R.k[i] = gld<u32x4>(kg + (t0 + row) * LDQK + ch * 8);
    }
    R.v = gld<u32x4>(vg + (t0 + vrow) * LDV + vch * 8);
    R.p = gld<u32x4>(pg + (size_t)n * 4 * 4096 + vrow * 64 + vch * 8);
  };
  auto issue1 = [&](int n1) { if (!ret) enext = gld<float>(eg + (size_t)n1 * (4 * DK) + (tid < DK ? tid : 0)); };
  auto step_fn = [&](Regs& R, int step, auto second_c) {
    constexpr bool second = decltype(second_c)::value;
    const int n = dir ? 127 - step : step;
    u32x4 ocur = {0u, 0u, 0u, 0u};
    if (second) ocur = gld<u32x4>(og + ((size_t)n * 64 + vrow) * LDO + vch * 8);
#pragma unroll
    for (int i = 0; i < NQ; ++i) {
      const int c = tid + 512 * i, row = c / (DK / 8), ch = c % (DK / 8);
      *(u32x4*)(lds + row * QS + ch * 16) = R.q[i];
      *(u32x4*)(lds + OFF_K + row * KS + ch * 16) = R.k[i];
    }
    *(u32x4*)(lds + OFF_V + vrow * VS + vch * 16) = ret ? scale8(R.v, ksc[vrow]) : R.v;
    {
      u32x4 w = R.p; unsigned ww[4] = {w.x, w.y, w.z, w.w};
#pragma unroll
      for (int e = 0; e < 4; ++e) {
        const int s0 = vch * 8 + 2 * e, s1 = s0 + 1;
        const bool k0 = dir ? (s0 > vrow) : (s0 <= vrow), k1 = dir ? (s1 > vrow) : (s1 <= vrow);
        ww[e] = (k0 ? (ww[e] & 0xffffu) : 0u) | (k1 ? (ww[e] & 0xffff0000u) : 0u);
      }
      *(u32x4*)(lds + OFF_PP + vrow * PS + vch * 16) = (u32x4){ww[0], ww[1], ww[2], ww[3]};
    }
    if (!ret) { if (tid < DK) *(float*)(lds + OFF_EE + tid * 4) = enext; }
    lds_barrier();
    issue(R, chunk_of(step + DEPTH));
    issue1(chunk_of(step + 1));
    bf16x8 vf[4];
    bf16x8 qa[2][2];
    auto ldq = [&](int jk, bf16x8 (&dst)[2]) {
      const int j = jk >> 1, ks = jk & 1;
#pragma unroll
      for (int tt = 0; tt < 2; ++tt) {
        const char* qp = lds + (32 * tt + r) * QS + (wr * RW + 32 * j + 16 * ks + 4 * hh) * 2;
        dst[tt] = cat8(*(const s16x4*)qp, *(const s16x4*)(qp + 16));
      }
    };
    f32x16 oacc[2];
    const f32x16 zero16 = {0.f, 0.f, 0.f, 0.f, 0.f, 0.f, 0.f, 0.f, 0.f, 0.f, 0.f, 0.f, 0.f, 0.f, 0.f, 0.f};
    {
      s16x4 t8[8];
      tr_issue8<4 * VS, 16 * VS>(ldsb + OFF_V + (8 * hh + qd) * VS + (32 * wc + 16 * g1 + 4 * pp) * 2, t8);
      const bf16x8 pa0 = *(const bf16x8*)(lds + OFF_PP + r * PS + (16 * wr + 8 * hh) * 2);
      const bf16x8 pa1 = *(const bf16x8*)(lds + OFF_PP + (32 + r) * PS + (16 * wr + 8 * hh) * 2);
      ldq(0, qa[0]);
      tr_wait8(t8);
#pragma unroll
      for (int s4 = 0; s4 < 4; ++s4) vf[s4] = cat8(t8[2 * s4], t8[2 * s4 + 1]);
      if (wr == 0) { oacc[0] = __builtin_amdgcn_mfma_f32_32x32x16_bf16(pa0, vf[0], zero16, 0, 0, 0); oacc[1] = __builtin_amdgcn_mfma_f32_32x32x16_bf16(pa1, vf[0], zero16, 0, 0, 0); }
      else if (wr == 1) { oacc[0] = __builtin_amdgcn_mfma_f32_32x32x16_bf16(pa0, vf[1], zero16, 0, 0, 0); oacc[1] = __builtin_amdgcn_mfma_f32_32x32x16_bf16(pa1, vf[1], zero16, 0, 0, 0); }
      else if (wr == 2) { oacc[0] = __builtin_amdgcn_mfma_f32_32x32x16_bf16(pa0, vf[2], zero16, 0, 0, 0); oacc[1] = __builtin_amdgcn_mfma_f32_32x32x16_bf16(pa1, vf[2], zero16, 0, 0, 0); }
      else { oacc[0] = __builtin_amdgcn_mfma_f32_32x32x16_bf16(pa0, vf[3], zero16, 0, 0, 0); oacc[1] = __builtin_amdgcn_mfma_f32_32x32x16_bf16(pa1, vf[3], zero16, 0, 0, 0); }
    }
#pragma unroll
    for (int jk = 0; jk < 2 * NT; ++jk) {
      if (jk + 1 < 2 * NT) ldq(jk + 1, qa[(jk + 1) & 1]);
      __builtin_amdgcn_sched_barrier(0);
      const int j = jk >> 1, ks = jk & 1;
      u32x4 sb;
      sb.x = pk(S[j][8 * ks + 0], S[j][8 * ks + 1]); sb.y = pk(S[j][8 * ks + 2], S[j][8 * ks + 3]);
      sb.z = pk(S[j][8 * ks + 4], S[j][8 * ks + 5]); sb.w = pk(S[j][8 * ks + 6], S[j][8 * ks + 7]);
      const bf16x8 bfr = __builtin_bit_cast(bf16x8, sb);
      __builtin_amdgcn_s_setprio(1);
      oacc[0] = __builtin_amdgcn_mfma_f32_32x32x16_bf16(qa[jk & 1][0], bfr, oacc[0], 0, 0, 0);
      oacc[1] = __builtin_amdgcn_mfma_f32_32x32x16_bf16(qa[jk & 1][1], bfr, oacc[1], 0, 0, 0);
      __builtin_amdgcn_s_setprio(0);
      __builtin_amdgcn_sched_barrier(0);
    }
#pragma unroll
    for (int tt = 0; tt < 2; ++tt)
#pragma unroll
      for (int e = 0; e < 16; ++e) {
        const int t = 32 * tt + (e & 3) + 8 * (e >> 2) + 4 * hh;
        *(float*)(lds + OFF_O + ((wr * 64 + t) * 64 + 32 * wc + r) * 4) = oacc[tt][e];
      }
    {
      s16x4 ka[8], kb[8];
      tr_issue8<4 * KS, 16 * KS>(ldsb + OFF_K + (8 * hh + qd) * KS + (wr * RW + 16 * g1 + 4 * pp) * 2, ka);
      if (NT == 2) tr_issue8<4 * KS, 16 * KS>(ldsb + OFF_K + (8 * hh + qd) * KS + (wr * RW + 32 + 16 * g1 + 4 * pp) * 2, kb);
      if (NT == 2) tr_wait16(ka, kb); else tr_wait8(ka);
      __builtin_amdgcn_s_setprio(1);
#pragma unroll
      for (int s4 = 0; s4 < 4; ++s4) {
        S[0] = __builtin_amdgcn_mfma_f32_32x32x16_bf16(cat8(ka[2 * s4], ka[2 * s4 + 1]), vf[s4], S[0], 0, 0, 0);
        if (NT == 2) S[NT - 1] = __builtin_amdgcn_mfma_f32_32x32x16_bf16(cat8(kb[2 * s4], kb[2 * s4 + 1]), vf[s4], S[NT - 1], 0, 0, 0);
      }
      __builtin_amdgcn_s_setprio(0);
    }
#pragma unroll
    for (int j = 0; j < NT; ++j) {
      if (ret) {
#pragma unroll
        for (int e = 0; e < 16; ++e) S[j][e] *= econst;
      } else {
#pragma unroll
        for (int gq = 0; gq < 4; ++gq) {
          const f32x4 ev = *(const f32x4*)(lds + OFF_EE + (wr * RW + 32 * j + 8 * gq + 4 * hh) * 4);
#pragma unroll
          for (int e = 0; e < 4; ++e) S[j][4 * gq + e] *= ev[e];
        }
      }
    }
    lds_barrier();
    {
      float sum[8];
#pragma unroll
      for (int e = 0; e < 8; ++e) sum[e] = 0.f;
#pragma unroll
      for (int w4 = 0; w4 < 4; ++w4) {
        const float* op = (const float*)(lds + OFF_O + ((w4 * 64 + vrow) * 64 + vch * 8) * 4);
        const f32x4 x0 = *(const f32x4*)op, x1 = *(const f32x4*)(op + 4);
        sum[0] += x0[0]; sum[1] += x0[1]; sum[2] += x0[2]; sum[3] += x0[3]; sum[4] += x1[0]; sum[5] += x1[1]; sum[6] += x1[2]; sum[7] += x1[3];
      }
      if (ret) {
        const float myqs = qsc[vrow];
#pragma unroll
        for (int e = 0; e < 8; ++e) sum[e] *= myqs;
      }
      if (second) {
        sum[0] += bflo(ocur.x); sum[1] += bfhi(ocur.x); sum[2] += bflo(ocur.y); sum[3] += bfhi(ocur.y);
        sum[4] += bflo(ocur.z); sum[5] += bfhi(ocur.z); sum[6] += bflo(ocur.w); sum[7] += bfhi(ocur.w);
      }
      u32x4 w; w.x = pk(sum[0], sum[1]); w.y = pk(sum[2], sum[3]); w.z = pk(sum[4], sum[5]); w.w = pk(sum[6], sum[7]);
      gst<u32x4>(og + ((size_t)n * 64 + vrow) * LDO + vch * 8, w);
      if (second) {
        float q2 = bflo(w.x) * bflo(w.x) + bfhi(w.x) * bfhi(w.x) + bflo(w.y) * bflo(w.y) + bfhi(w.y) * bfhi(w.y) +
                   bflo(w.z) * bflo(w.z) + bfhi(w.z) * bfhi(w.z) + bflo(w.w) * bflo(w.w) + bfhi(w.w) * bfhi(w.w);
        q2 += __shfl_xor(q2, 1); q2 += __shfl_xor(q2, 2); q2 += __shfl_xor(q2, 4);
        if (vch == 0) gst<float>(a.ssp + ((size_t)b * L_ + (size_t)n * 64 + vrow) * 32 + h * 8 + slice, q2);
      }
    }
  };
  if (active) {
    issue(RA, chunk_of(0)); issue1(chunk_of(0));
    if (DEPTH == 2) {
      issue(RB, chunk_of(1));
      for (int step = 0; step < 64; step += 2) { step_fn(RA, step, FalseC{}); step_fn(RB, step + 1, FalseC{}); }
    } else {
      for (int step = 0; step < 64; ++step) step_fn(RA, step, FalseC{});
    }
  }
  xcd_barrier(xb);
  if (active) {
    if (DEPTH == 2) {
      for (int step = 64; step < 128; step += 2) { step_fn(RA, step, TrueC{}); step_fn(RB, step + 1, TrueC{}); }
    } else {
      for (int step = 64; step < 128; ++step) step_fn(RA, step, TrueC{});
    }
  }
}

__global__ void __launch_bounds__(512, 2) mega(Params p) {
  cg::grid_group grid = cg::this_grid();
  extern __shared__ __attribute__((aligned(16))) char lds[];
  char* ws = KP(ws);
  volatile LAS unsigned* xst = (volatile LAS unsigned*)(LAS char*)(lds + (LDS_BYTES - 16));
  if (threadIdx.x == 0) { xst[0] = 0u; xst[1] = 0u; }
  __syncthreads();
  XcdBarrier xb = xcd_barrier_post((unsigned*)(ws + OFF_BAR), xst);
  rw_phase(KP(x), (bf16_t*)(ws + OFF_D), nullptr, nullptr, (float*)(ws + OFF_RS + 512 * 1024), nullptr);
  wconv_layer(0, (float*)lds);
  if (gridDim.x == 0x7fffffffu) grid.sync();
  xcd_barrier(xb);

  for (int layer = 0; layer < 4; ++layer) {
    const int kind0 = layer % 3;
    const int nsteps = (kind0 == 0 ? 6 : kind0 == 1 ? 4 : 7) + 3;
    const int nmix = nsteps - 3;
    for (int s = 0; s < nsteps; ++s) {
      int lyr = layer; asm volatile("" : "+s"(lyr));
      const int kind = (lyr == 3) ? 0 : lyr;
      char* ws = KP(ws);
      bf16_t* W = (bf16_t*)(ws + OFF_W);
      bf16_t* bA = (bf16_t*)(ws + OFF_A); bf16_t* bB = (bf16_t*)(ws + OFF_B); bf16_t* bC = (bf16_t*)(ws + OFF_C); bf16_t* bU = (bf16_t*)(ws + OFF_D);
      bf16_t* bP = (bf16_t*)(ws + OFF_P);
      float* rs = (float*)(ws + OFF_RS); float* Eb = (float*)(ws + OFF_E); float* t1 = (float*)(ws + OFF_T1);
      float* rh = (float*)(ws + OFF_RS + 512 * 1024);
      const float* G = KP(norm_gains);
      const float* gl = G + lyr * 4096;
      GemmDesc g{}; bool is_gemm = false;

      const int ms = s - nmix;
      if (ms == 0) { is_gemm = true; g.A = bU; g.Bt = W + W_UP; g.N = 4096; g.K = 1024; g.epi = EPI_RELU2; g.o0 = bA; g.rowscale = rh; }
      else if (ms == 1) { is_gemm = true; g.A = bA; g.Bt = W + W_DN; g.N = 1024; g.K = 4096; g.epi = EPI_PLAIN; g.o0 = bC; }
      else if (ms == 2) {
        rw_phase(nullptr, bU, bC, gl + 3072, rh, (lyr < 3) ? nullptr : KP(out));
        if (lyr < 3) wconv_layer(lyr + 1, (float*)lds);
      } else if (kind == 0) {
        const float* dec = KP(ret_decay) + (lyr / 3) * 8;
        if (s == 0) { is_gemm = true; g.A = bU; g.Bt = W + W_IN; g.N = 4096; g.K = 1024; g.epi = EPI_RETQKV; g.o0 = bA; g.o1 = bB; g.pos = KP(pos); g.rowscale = rh; }
        else if (s == 1) ppass_phase<256, false>(bA, bA + 1024, nullptr, nullptr, 2048, dec, bP);
        else if (s == 2) {
          ScanArgs a{}; a.q0 = a.q1 = bA; a.k0 = a.k1 = bA + 1024; a.v = bB; a.P = bP; a.o = bC;
          a.E = nullptr; a.decay = dec; a.ssp = t1;
          scan_phase<256>(a, lds, xb);
        }
        else if (s == 3) { is_gemm = true; g.A = bU; g.Bt = W + W_G; g.N = 2048; g.K = 1024; g.epi = EPI_GATE; g.dvshift = 9; g.o0 = bC; g.f0 = t1; g.c0 = nullptr; g.rowscale = rh; }
        else if (s == 4) { is_gemm = true; g.A = bC; g.Bt = W + W_OUT; g.N = 1024; g.K = 2048; g.epi = EPI_PLAIN; g.o0 = bA; }
        else rw_phase(nullptr, bU, bA, gl + 1024, rh, nullptr);
      } else if (kind == 1) {
        if (s == 0) { is_gemm = true; g.A = bU; g.Bt = W + W_IN; g.N = 2048; g.K = 1024; g.epi = EPI_GLU; g.o0 = bA; g.bias = KP(conv_b_in); g.rowscale = rh; }
        else if (s == 1) conv_phase(bA, bB, lds);
        else if (s == 2) { is_gemm = true; g.A = bB; g.Bt = W + W_OUT; g.N = 1024; g.K = 1024; g.epi = EPI_PLAIN; g.o0 = bC; g.bias = KP(conv_b_out); }
        else rw_phase(nullptr, bU, bC, gl + 1024, rh, nullptr);
      } else {
        bf16_t* gv = bA + (size_t)T_ * 1024; bf16_t* qkb = bB + (size_t)T_ * 1024; bf16_t* gy = bC + (size_t)T_ * 1024;
        if (s == 0) { is_gemm = true; g.A = bU; g.Bt = W + W_IN; g.N = 2304; g.K = 1024; g.epi = EPI_GLA; g.o0 = bA; g.o1 = gv; g.f0 = t1; g.rowscale = rh; }
        else if (s == 1) glaprep_phase(bA, t1, bB, qkb, Eb, lds);
        else if (s == 2) ppass_phase<128, true>(bB, bB + 512, qkb, qkb + 512, 1024, nullptr, bP);
        else if (s == 3) {
          ScanArgs a{}; a.q0 = bB; a.k0 = bB + 512; a.q1 = qkb; a.k1 = qkb + 512; a.v = gv; a.P = bP; a.o = bC;
          a.E = Eb; a.decay = nullptr; a.ssp = t1;
          scan_phase<128>(a, lds, xb);
        }
        else if (s == 4) { is_gemm = true; g.A = bU; g.Bt = W + W_G; g.N = 1024; g.K = 1024; g.epi = EPI_GATE; g.dvshift = 8; g.o0 = bC; g.f0 = t1; g.c0 = KP(gla_ng); g.rowscale = rh; }
        else if (s == 5) { is_gemm = true; g.A = bC; g.Bt = W + W_OUT; g.N = 1024; g.K = 1024; g.epi = EPI_PLAIN; g.o0 = gy; }
        else rw_phase(nullptr, bU, gy, gl + 1024, rh, nullptr);
      }
      if (is_gemm) gemm_phase(g, (LAS unsigned char*)lds);
      xcd_barrier(xb);
    }
  }
}

extern "C" void kernel_launch(void* const* d_in, const int* in_sizes, int n_in, void* d_out, int out_size,
                              void* d_ws, size_t ws_size, hipStream_t stream) {
  static int grid_blocks = 0;
  if (!grid_blocks) {
    (void)hipFuncSetAttribute((const void*)mega, hipFuncAttributeMaxDynamicSharedMemorySize, (int)LDS_BYTES);
    int dev = 0, cus = 0;
    (void)hipGetDevice(&dev);
    (void)hipDeviceGetAttribute(&cus, hipDeviceAttributeMultiprocessorCount, dev);
    grid_blocks = cus;
  }
  if (ws_size < 505 * MiB) { fprintf(stderr, "workspace too small: %zu\n", ws_size); return; }
  Params p{};
  p.x = (const float*)d_in[0]; p.pos = (const int*)d_in[1]; p.norm_gains = (const float*)d_in[2];
  p.ret_w_in = (const float*)d_in[3]; p.ret_decay = (const float*)d_in[4]; p.ret_w_out = (const float*)d_in[5];
  p.conv_w_in = (const float*)d_in[6]; p.conv_b_in = (const float*)d_in[7]; p.conv_w_dw = (const float*)d_in[8]; p.conv_b_dw = (const float*)d_in[9];
  p.conv_ln_g = (const float*)d_in[10]; p.conv_ln_b = (const float*)d_in[11]; p.conv_w_out = (const float*)d_in[12]; p.conv_b_out = (const float*)d_in[13];
  p.gla_w_in = (const float*)d_in[14]; p.gla_w1 = (const float*)d_in[15]; p.gla_w2 = (const float*)d_in[16]; p.gla_gb = (const float*)d_in[17];
  p.gla_ng = (const float*)d_in[18]; p.gla_w_out = (const float*)d_in[19]; p.mlp_up = (const float*)d_in[20]; p.mlp_down = (const float*)d_in[21];
  p.out = (float*)d_out; p.ws = (char*)d_ws;
  (void)hipMemsetAsync((char*)d_ws + OFF_BAR, 0, XCD_BAR_WORDS * 4, stream);
  void* args[] = {&p};
  hipError_t e = hipLaunchCooperativeKernel((void*)mega, dim3(grid_blocks), dim3(512), args, LDS_BYTES, stream);
  if (e != hipSuccess) fprintf(stderr, "cooperative launch failed: %s (grid %d)\n", hipGetErrorString(e), grid_blocks);
}
```

```cpp
#include <hip/hip_runtime.h>
#include <hip/hip_cooperative_groups.h>
#include <cstdio>
#include <cstdint>
namespace cg = cooperative_groups;

#define DI __device__ __forceinline__
typedef unsigned short bf16_t;
typedef short bf16x8 __attribute__((ext_vector_type(8)));
typedef short s16x4 __attribute__((ext_vector_type(4)));
typedef float f32x2 __attribute__((ext_vector_type(2)));
typedef float f32x4 __attribute__((ext_vector_type(4)));
typedef float f32x16 __attribute__((ext_vector_type(16)));
typedef unsigned u32x2 __attribute__((ext_vector_type(2)));
typedef unsigned u32x4 __attribute__((ext_vector_type(4)));
typedef __bf16 bf2_t __attribute__((ext_vector_type(2)));

constexpr int T_ = 32768, L_ = 8192;
constexpr float EPS = 1e-6f;
constexpr size_t MiB = 1u << 20;
constexpr size_t OFF_W = 0, OFF_A = 32 * MiB, OFF_B = 160 * MiB, OFF_C = 288 * MiB, OFF_D = 416 * MiB, OFF_P = 480 * MiB,
                 OFF_RS = 496 * MiB, OFF_E = 497 * MiB, OFF_T1 = 500 * MiB, OFF_BAR = 504 * MiB;
constexpr size_t LDS_BYTES = 163840;

struct Params {
  const float* x; const int* pos; const float* norm_gains;
  const float* ret_w_in; const float* ret_decay; const float* ret_w_out;
  const float* conv_w_in; const float* conv_b_in; const float* conv_w_dw; const float* conv_b_dw; const float* conv_ln_g; const float* conv_ln_b;
  const float* conv_w_out; const float* conv_b_out;
  const float* gla_w_in; const float* gla_w1; const float* gla_w2; const float* gla_gb; const float* gla_ng; const float* gla_w_out;
  const float* mlp_up; const float* mlp_down;
  float* out; char* ws;
};

DI unsigned pk(float lo, float hi) { f32x2 v = {lo, hi}; bf2_t b = __builtin_convertvector(v, bf2_t); return __builtin_bit_cast(unsigned, b); }
DI float bflo(unsigned w) { return __uint_as_float(w << 16); }
DI float bfhi(unsigned w) { return __uint_as_float(w & 0xffff0000u); }
DI float bf1(bf16_t h) { return __uint_as_float(((unsigned)h) << 16); }
DI bf16_t tobf(float f) { return (bf16_t)(pk(f, 0.f) & 0xffffu); }
DI float sigmoidf_(float x) { return 1.0f / (1.0f + __expf(-x)); }
DI const void* karg(int off) {
  const char* kp = (const char*)__builtin_amdgcn_kernarg_segment_ptr();
  const void* r;
  asm volatile("s_load_dwordx2 %0, %1, %2\n\ts_waitcnt lgkmcnt(0)" : "=s"(r) : "s"(kp), "s"(off) : "memory");
  return r;
}
typedef __attribute__((address_space(1))) char gchar_t;
#define KP(f) ((decltype(Params::f))(char*)(gchar_t*)(char*)karg((int)offsetof(Params, f)))
#define GAS __attribute__((address_space(1)))
template <class T> DI T gld(const void* p) { return *(const GAS T*)(const GAS char*)(const char*)p; }
template <class T> DI void gst(void* p, T v) { *(GAS T*)(GAS char*)(char*)p = v; }
DI float log_sigmoid_(float x) {
  const float e = __expf(-fabsf(x));
  const float l1p = (e < 0.0625f) ? e * (1.0f + e * (-0.5f + e * (0.33333334f + e * (-0.25f + e * (0.2f + e * (-0.16666667f + e * 0.14285715f)))))) : __logf(1.0f + e);
  return fminf(x, 0.f) - l1p;
}
DI void lds_barrier() { asm volatile("s_waitcnt lgkmcnt(0)" ::: "memory"); __builtin_amdgcn_s_barrier(); asm volatile("" ::: "memory"); }
DI int obid() { int b = blockIdx.x; asm volatile("" : "+s"(b)); return b; }
DI int otid() { int t = threadIdx.x; asm volatile("" : "+v"(t)); return t; }
DI float wave_sum(float v) {
#pragma unroll
  for (int o = 1; o < 64; o <<= 1) v += __shfl_xor(v, o);
  return v;
}


#define XB_TMO      128
#define XB_XCNT(j)  (256  + 64 * (j))
#define XB_XSUB(j)  (1280 + 64 * (j))
#define XB_XGEN(j)  (2304 + 64 * (j))
#define XB_TOP      3328
#define XB_TOPGEN   3392
#define XCD_BAR_WORDS 3456
#define XB_SPIN_CAP (1u << 18)
#define LAS __attribute__((address_space(3)))
DI unsigned xb_ld(unsigned* p)              { return __hip_atomic_load(p, __ATOMIC_RELAXED, __HIP_MEMORY_SCOPE_AGENT); }
DI unsigned xb_add(unsigned* p, unsigned v) { return __hip_atomic_fetch_add(p, v, __ATOMIC_RELAXED, __HIP_MEMORY_SCOPE_AGENT); }
DI unsigned xb_xcc_id() { return (unsigned)__builtin_amdgcn_s_getreg((3 << 11) | 20) & 0xFu; }
#define XB_SPIN(cond, bar) do { unsigned _sp = 0; while (cond) { __builtin_amdgcn_s_sleep(1); \
    if ((++_sp & 255u) == 0u) { if (xb_ld(&(bar)[XB_TMO])) break; if (_sp > XB_SPIN_CAP) { atomicAdd(&(bar)[XB_TMO], 1u); break; } } } } while (0)
struct XcdBarrier { unsigned* bar; unsigned x; volatile LAS unsigned* st; };
DI XcdBarrier xcd_barrier_post(unsigned* bar, volatile LAS unsigned* st) {
  XcdBarrier b; b.bar = bar; b.x = xb_xcc_id(); b.st = st;
  if (threadIdx.x == 0) (void)xb_add(&bar[XB_XCNT(b.x)], 1u);
  return b;
}
DI void xcd_barrier_complete(unsigned* bar, unsigned x, unsigned& nloc, unsigned& nx) {
  const unsigned G = gridDim.x * gridDim.y * gridDim.z;
  unsigned sum, cnt, mine, sp = 0u;
  for (;;) {
    sum = 0u; cnt = 0u; mine = 0u;
#pragma unroll
    for (unsigned j = 0; j < 16; ++j) { const unsigned c = xb_ld(&bar[XB_XCNT(j)]); sum += c; cnt += (c > 0u) ? 1u : 0u; mine = (j == x) ? c : mine; }
    if (sum == G) break;
    __builtin_amdgcn_s_sleep(1);
    if ((++sp & 255u) == 0u) { if (xb_ld(&bar[XB_TMO])) break; if (sp > XB_SPIN_CAP) { atomicAdd(&bar[XB_TMO], 1u); break; } }
  }
  nloc = mine > 0u ? mine : 1u; nx = cnt > 0u ? cnt : 1u;
}
DI void xcd_barrier(const XcdBarrier& b) {
  asm volatile("s_waitcnt vmcnt(0)" ::: "memory");
  __syncthreads();
  if (threadIdx.x == 0) {
    unsigned* bar = b.bar;
    __builtin_amdgcn_s_waitcnt(0);
    unsigned nloc = b.st[0], nx = b.st[1];
    if (nloc == 0u) { xcd_barrier_complete(bar, b.x, nloc, nx); b.st[0] = nloc; b.st[1] = nx; }
    const unsigned old = xb_add(&bar[XB_XSUB(b.x)], 1u);
    const unsigned gen = old / nloc;
    if (old + 1u == (gen + 1u) * nloc) {
      __builtin_amdgcn_fence(__ATOMIC_RELEASE, "agent");
      asm volatile("s_waitcnt vmcnt(0)" ::: "memory");
      const unsigned og = xb_add(&bar[XB_TOP], 1u);
      const unsigned tg = og / nx;
      if (og + 1u == (tg + 1u) * nx) xb_add(&bar[XB_TOPGEN], 1u);
      else XB_SPIN(xb_ld(&bar[XB_TOPGEN]) == tg, bar);
      __builtin_amdgcn_fence(__ATOMIC_ACQUIRE, "agent");
      xb_add(&bar[XB_XGEN(b.x)], 1u);
      asm volatile("s_waitcnt vmcnt(0)" ::: "memory");
    } else {
      XB_SPIN(xb_ld(&bar[XB_XGEN(b.x)]) == gen, bar);
      __builtin_amdgcn_fence(__ATOMIC_ACQUIRE, "agent");
      asm volatile("s_waitcnt vmcnt(0)" ::: "memory");
    }
  }
  __syncthreads();
}

DI float wsrc(const float* src, int ld, int mode, const float* aux, int k, int n) {
  if (mode == 0) return gld<float>(src + (size_t)k * ld + n);
  if (mode == 1) { int c = ((n >> 7) & 1) * 1024 + (n >> 8) * 128 + (n & 127); return gld<float>(src + (size_t)k * ld + c); }
  if (n < 2048) return gld<float>(src + (size_t)k * ld + n);
  if (n < 2080) { int j = n - 2048; return gld<float>(aux + ((size_t)(j >> 4) * 1024 + k) * 16 + (j & 15)); }
  return 0.f;
}
DI void wconv_job(const float* src, int ld, int K, int Nd, bf16_t* dst, int mode, const float* aux, float* tile, const float* gain) {
  const int tk = K >> 6, tn = Nd >> 6, nt = tk * tn, tid = otid();
  for (int t = blockIdx.x; t < nt; t += gridDim.x) {
    const int k0 = (t % tk) << 6, n0 = (t / tk) << 6;
    __syncthreads();
    if (mode == 0) {
#pragma unroll
      for (int i = 0; i < 2; ++i) {
        const int kk = (tid >> 4) + 32 * i, n4 = (tid & 15) * 4;
        f32x4 v = gld<f32x4>(src + (size_t)(k0 + kk) * ld + n0 + n4);
        if (gain) v = v * gld<float>(gain + k0 + kk);
        tile[kk * 65 + n4] = v[0]; tile[kk * 65 + n4 + 1] = v[1]; tile[kk * 65 + n4 + 2] = v[2]; tile[kk * 65 + n4 + 3] = v[3];
      }
    } else {
#pragma unroll
      for (int i = 0; i < 8; ++i) { int kk = (tid >> 6) + 8 * i, nn = tid & 63; tile[kk * 65 + nn] = wsrc(src, ld, mode, aux, k0 + kk, n0 + nn) * (gain ? gld<float>(gain + k0 + kk) : 1.0f); }
    }
    __syncthreads();
    const int nn = tid >> 3, k8 = (tid & 7) * 8;
    u32x4 w;
    w.x = pk(tile[(k8 + 0) * 65 + nn], tile[(k8 + 1) * 65 + nn]); w.y = pk(tile[(k8 + 2) * 65 + nn], tile[(k8 + 3) * 65 + nn]);
    w.z = pk(tile[(k8 + 4) * 65 + nn], tile[(k8 + 5) * 65 + nn]); w.w = pk(tile[(k8 + 6) * 65 + nn], tile[(k8 + 7) * 65 + nn]);
    gst<u32x4>(dst + (size_t)(n0 + nn) * K + k0 + k8, w);
  }
}
constexpr size_t W_IN = 0;
constexpr size_t W_G = 4096u * 1024u;
constexpr size_t W_OUT = 6144u * 1024u;
constexpr size_t W_UP = 8192u * 1024u;
constexpr size_t W_DN = 12288u * 1024u;
DI void wconv_layer(int layer, float* tile) {
  bf16_t* W = (bf16_t*)(KP(ws) + OFF_W);
  const int kind = layer % 3, j = layer / 3;
  const float* g0 = KP(norm_gains) + layer * 4096;
  const float* g2 = g0 + 2048;
  if (kind == 0) {
    const float* win = KP(ret_w_in) + (size_t)j * 1024 * 6144;
    wconv_job(win, 6144, 1024, 4096, W + W_IN, 0, nullptr, tile, g0);
    wconv_job(win + 4096, 6144, 1024, 2048, W + W_G, 0, nullptr, tile, g0);
    wconv_job(KP(ret_w_out) + (size_t)j * 2048 * 1024, 1024, 2048, 1024, W + W_OUT, 0, nullptr, tile, nullptr);
  } else if (kind == 1) {
    wconv_job(KP(conv_w_in), 2048, 1024, 2048, W + W_IN, 1, nullptr, tile, g0);
    wconv_job(KP(conv_w_out), 1024, 1024, 1024, W + W_OUT, 0, nullptr, tile, nullptr);
  } else {
    wconv_job(KP(gla_w_in), 3072, 1024, 2304, W + W_IN, 2, KP(gla_w1), tile, g0);
    wconv_job(KP(gla_w_in) + 2048, 3072, 1024, 1024, W + W_G, 0, nullptr, tile, g0);
    wconv_job(KP(gla_w_out), 1024, 1024, 1024, W + W_OUT, 0, nullptr, tile, nullptr);
  }
  wconv_job(KP(mlp_up) + (size_t)layer * 1024 * 4096, 4096, 1024, 4096, W + W_UP, 0, nullptr, tile, g2);
  wconv_job(KP(mlp_down) + (size_t)layer * 4096 * 1024, 1024, 4096, 1024, W + W_DN, 0, nullptr, tile, nullptr);
}

DI void rw_phase(const float* x, bf16_t* hb, const bf16_t* y, const float* gpost, float* rh, float* fout) {
  const int tid_ = otid(), wid = tid_ >> 6, lane = tid_ & 63;
  for (int row = blockIdx.x * 8 + wid; row < T_; row += gridDim.x * 8) {
    float hv[16];
    if (x) {
      const float* hp = x + (size_t)row * 1024;
#pragma unroll
      for (int c = 0; c < 2; ++c) {
        const f32x4 a = gld<f32x4>(hp + 512 * c + 8 * lane), b = gld<f32x4>(hp + 512 * c + 8 * lane + 4);
        hv[8 * c + 0] = a[0]; hv[8 * c + 1] = a[1]; hv[8 * c + 2] = a[2]; hv[8 * c + 3] = a[3];
        hv[8 * c + 4] = b[0]; hv[8 * c + 5] = b[1]; hv[8 * c + 6] = b[2]; hv[8 * c + 7] = b[3];
      }
    } else {
#pragma unroll
      for (int c = 0; c < 2; ++c) {
        const u32x4 w = gld<u32x4>(hb + (size_t)row * 1024 + 512 * c + 8 * lane);
        hv[8 * c + 0] = bflo(w.x); hv[8 * c + 1] = bfhi(w.x); hv[8 * c + 2] = bflo(w.y); hv[8 * c + 3] = bfhi(w.y);
        hv[8 * c + 4] = bflo(w.z); hv[8 * c + 5] = bfhi(w.z); hv[8 * c + 6] = bflo(w.w); hv[8 * c + 7] = bfhi(w.w);
      }
    }
    if (y) {
      float yv[16]; float ss = 0.f;
#pragma unroll
      for (int c = 0; c < 2; ++c) {
        const u32x4 w = gld<u32x4>(y + (size_t)row * 1024 + 512 * c + 8 * lane);
        yv[8 * c + 0] = bflo(w.x); yv[8 * c + 1] = bfhi(w.x); yv[8 * c + 2] = bflo(w.y); yv[8 * c + 3] = bfhi(w.y);
        yv[8 * c + 4] = bflo(w.z); yv[8 * c + 5] = bfhi(w.z); yv[8 * c + 6] = bflo(w.w); yv[8 * c + 7] = bfhi(w.w);
      }
#pragma unroll
      for (int i = 0; i < 16; ++i) ss += yv[i] * yv[i];
      ss = wave_sum(ss);
      const float ry = rsqrtf(ss * (1.0f / 1024.0f) + EPS);
#pragma unroll
      for (int c = 0; c < 2; ++c) {
        const f32x4 g0 = gld<f32x4>(gpost + 512 * c + 8 * lane), g1 = gld<f32x4>(gpost + 512 * c + 8 * lane + 4);
#pragma unroll
        for (int i = 0; i < 4; ++i) { hv[8 * c + i] += yv[8 * c + i] * ry * g0[i]; hv[8 * c + 4 + i] += yv[8 * c + 4 + i] * ry * g1[i]; }
      }
    }
    if (fout) {
      float* op = fout + (size_t)row * 1024;
#pragma unroll
      for (int c = 0; c < 2; ++c) {
        gst<f32x4>(op + 512 * c + 8 * lane, (f32x4){hv[8 * c], hv[8 * c + 1], hv[8 * c + 2], hv[8 * c + 3]});
        gst<f32x4>(op + 512 * c + 8 * lane + 4, (f32x4){hv[8 * c + 4], hv[8 * c + 5], hv[8 * c + 6], hv[8 * c + 7]});
      }
    } else {
      float s2 = 0.f;
#pragma unroll
      for (int c = 0; c < 2; ++c) {
        u32x4 w;
        w.x = pk(hv[8 * c + 0], hv[8 * c + 1]); w.y = pk(hv[8 * c + 2], hv[8 * c + 3]); w.z = pk(hv[8 * c + 4], hv[8 * c + 5]); w.w = pk(hv[8 * c + 6], hv[8 * c + 7]);
        gst<u32x4>(hb + (size_t)row * 1024 + 512 * c + 8 * lane, w);
        s2 += bflo(w.x) * bflo(w.x) + bfhi(w.x) * bfhi(w.x) + bflo(w.y) * bflo(w.y) + bfhi(w.y) * bfhi(w.y) +
              bflo(w.z) * bflo(w.z) + bfhi(w.z) * bfhi(w.z) + bflo(w.w) * bflo(w.w) + bfhi(w.w) * bfhi(w.w);
      }
      s2 = wave_sum(s2);
      if (lane == 0) gst<float>(rh + row, rsqrtf(s2 * (1.0f / 1024.0f) + EPS));
    }
  }
}

DI void stats_phase(const bf16_t* o, int HW, float* rs) {
  const int tid_ = otid(), wid = tid_ >> 6, lane = tid_ & 63;
  for (int row = blockIdx.x * 8 + wid; row < T_; row += gridDim.x * 8) {
    if (HW == 2048) {
#pragma unroll
      for (int c = 0; c < 4; ++c) {
        u32x4 w = gld<u32x4>(o + (size_t)row * 2048 + 512 * c + 8 * lane);
        float s = bflo(w.x) * bflo(w.x) + bfhi(w.x) * bfhi(w.x) + bflo(w.y) * bflo(w.y) + bfhi(w.y) * bfhi(w.y) +
                  bflo(w.z) * bflo(w.z) + bfhi(w.z) * bfhi(w.z) + bflo(w.w) * bflo(w.w) + bfhi(w.w) * bfhi(w.w);
        s = wave_sum(s);
        if (lane == 0) gst<float>(rs + row * 4 + c, rsqrtf(s * (1.0f / 512.0f) + EPS));
      }
    } else {
#pragma unroll
      for (int c = 0; c < 2; ++c) {
        u32x4 w = gld<u32x4>(o + (size_t)row * 1024 + 512 * c + 8 * lane);
        float s = bflo(w.x) * bflo(w.x) + bfhi(w.x) * bfhi(w.x) + bflo(w.y) * bflo(w.y) + bfhi(w.y) * bfhi(w.y) +
                  bflo(w.z) * bflo(w.z) + bfhi(w.z) * bfhi(w.z) + bflo(w.w) * bflo(w.w) + bfhi(w.w) * bfhi(w.w);
#pragma unroll
        for (int of = 1; of < 32; of <<= 1) s += __shfl_xor(s, of);
        if ((lane & 31) == 0) gst<float>(rs + row * 4 + 2 * c + (lane >> 5), rsqrtf(s * (1.0f / 256.0f) + EPS));
      }
    }
  }
}

constexpr int BM = 256, BK = 64, HALF = 128, NXCD = 8, WGM = 4, HT = HALF * BK;
enum { EPI_PLAIN = 0, EPI_RELU2 = 1, EPI_RETQKV = 2, EPI_GATE = 3, EPI_GLU = 4, EPI_GLA = 5 };
struct GemmDesc {
  const bf16_t* A; const bf16_t* Bt; int N; int K; int epi; int dvshift;
  bf16_t* o0; bf16_t* o1; float* f0; const float* bias; const float* c0; const int* pos; const float* rowscale;
};
DI int lds_byte(int r, int c) { int st = (r >> 4) * 2 + (c >> 5), rr = r & 15, cc = c & 31, ob = rr * 64 + cc * 2; return st * 1024 + (ob ^ (((ob >> 9) & 1) << 5)); }
DI void stage_rc(int b, int& R, int& C) { int st = b / 1024, sb = b % 1024, swz = sb ^ (((sb >> 9) & 1) << 5); R = (st >> 1) * 16 + swz / 64; C = (st & 1) * 32 + (swz % 64) / 2; }

DI void gemm_epilogue(const GemmDesc& g, f32x4 (&acc)[2][2][4][2], int brow, int bcol, int wr, int wc, int fr, int fq) {
  const int epi = g.epi;
  const int rowb = brow + wr * 64 + fr, colb = bcol + wc * 32 + 8 * fq;
  if (epi == EPI_PLAIN || epi == EPI_RELU2) {
    const int N = g.N;
#pragma unroll
    for (int bj = 0; bj < 2; ++bj) {
      const int col = colb + bj * HALF;
      f32x4 b0 = {0.f, 0.f, 0.f, 0.f}, b1 = b0;
      if (g.bias) { b0 = gld<f32x4>(g.bias + col); b1 = gld<f32x4>(g.bias + col + 4); }
#pragma unroll
      for (int ai = 0; ai < 2; ++ai)
#pragma unroll
        for (int m = 0; m < 4; ++m) {
          const int row = rowb + ai * HALF + m * 16;
          f32x4 v0 = acc[ai][bj][m][0], v1 = acc[ai][bj][m][1];
          if (g.rowscale) { const float ru = gld<float>(g.rowscale + row); v0 = v0 * ru; v1 = v1 * ru; }
          v0 = v0 + b0; v1 = v1 + b1;
          if (epi == EPI_RELU2) {
#pragma unroll
            for (int j = 0; j < 4; ++j) { float r0 = fmaxf(v0[j], 0.f), r1 = fmaxf(v1[j], 0.f); v0[j] = r0 * r0; v1[j] = r1 * r1; }
          }
          u32x4 w; w.x = pk(v0[0], v0[1]); w.y = pk(v0[2], v0[3]); w.z = pk(v1[0], v1[1]); w.w = pk(v1[2], v1[3]);
          gst<u32x4>(g.o0 + (size_t)row * N + col, w);
        }
    }
  } else if (epi == EPI_RETQKV) {
    if (bcol < 2048) {
      const float sc = (bcol < 1024) ? 0.0625f : 1.0f;
      const int d0 = wc * 32 + 8 * fq;
      float fr_[8];
#pragma unroll
      for (int j = 0; j < 8; ++j) fr_[j] = exp2f(-(float)(d0 + j) * (13.287712379549449f / 128.0f)) * 0.15915494309189535f;
#pragma unroll
      for (int ai = 0; ai < 2; ++ai)
#pragma unroll
        for (int m = 0; m < 4; ++m) {
          const int row = rowb + ai * HALF + m * 16;
          const float pf = (float)gld<int>(g.pos + row);
          const float scr = sc * gld<float>(g.rowscale + row);
          float y1[8], y2[8];
#pragma unroll
          for (int n = 0; n < 2; ++n) {
            const f32x4 x1 = acc[ai][0][m][n], x2 = acc[ai][1][m][n];
#pragma unroll
            for (int j = 0; j < 4; ++j) {
              float rev = pf * fr_[4 * n + j]; rev = rev - rintf(rev);
              const float sn = __builtin_amdgcn_sinf(rev), cs = __builtin_amdgcn_cosf(rev);
              y1[4 * n + j] = (x1[j] * cs - x2[j] * sn) * scr; y2[4 * n + j] = (x2[j] * cs + x1[j] * sn) * scr;
            }
          }
          u32x4 w1, w2;
          w1.x = pk(y1[0], y1[1]); w1.y = pk(y1[2], y1[3]); w1.z = pk(y1[4], y1[5]); w1.w = pk(y1[6], y1[7]);
          w2.x = pk(y2[0], y2[1]); w2.y = pk(y2[2], y2[3]); w2.z = pk(y2[4], y2[5]); w2.w = pk(y2[6], y2[7]);
          bf16_t* op = g.o0 + (size_t)row * 2048 + bcol + d0;
          gst<u32x4>(op, w1); gst<u32x4>(op + 128, w2);
        }
    } else {
#pragma unroll
      for (int bj = 0; bj < 2; ++bj) {
        const int col = colb - 2048 + bj * HALF;
#pragma unroll
        for (int ai = 0; ai < 2; ++ai)
#pragma unroll
          for (int m = 0; m < 4; ++m) {
            const int row = rowb + ai * HALF + m * 16;
            const float ru = gld<float>(g.rowscale + row);
            const f32x4 v0 = acc[ai][bj][m][0] * ru, v1 = acc[ai][bj][m][1] * ru;
            u32x4 w; w.x = pk(v0[0], v0[1]); w.y = pk(v0[2], v0[3]); w.z = pk(v1[0], v1[1]); w.w = pk(v1[2], v1[3]);
            gst<u32x4>(g.o1 + (size_t)row * 2048 + col, w);
          }
      }
    }
  } else if (epi == EPI_GATE) {
    const int N = g.N, dvm = (1 << g.dvshift) - 1;
#pragma unroll
    for (int bj = 0; bj < 2; ++bj) {
      const int col = colb + bj * HALF;
      f32x4 g0 = {1.f, 1.f, 1.f, 1.f}, g1 = g0;
      if (g.c0) { g0 = gld<f32x4>(g.c0 + (col & dvm)); g1 = gld<f32x4>(g.c0 + (col & dvm) + 4); }
      const int head = col >> g.dvshift;
#pragma unroll
      for (int ai = 0; ai < 2; ++ai)
#pragma unroll
        for (int m = 0; m < 4; ++m) {
          const int row = rowb + ai * HALF + m * 16;
          float rs;
          { const float* sp = g.f0 + (size_t)row * 32 + head * 8;
            const f32x4 s0 = gld<f32x4>(sp); float ssum = (s0[0] + s0[1]) + (s0[2] + s0[3]);
            if (g.dvshift == 9) { const f32x4 s1 = gld<f32x4>(sp + 4); ssum += (s1[0] + s1[1]) + (s1[2] + s1[3]); }
            rs = rsqrtf(ssum * (g.dvshift == 9 ? (1.0f / 512.0f) : (1.0f / 256.0f)) + EPS); }
          bf16_t* op = g.o0 + (size_t)row * N + col;
          const u32x4 ow = gld<u32x4>(op);
          const float ru = gld<float>(g.rowscale + row);
          const f32x4 v0 = acc[ai][bj][m][0] * ru, v1 = acc[ai][bj][m][1] * ru;
          float o[8] = {bflo(ow.x), bfhi(ow.x), bflo(ow.y), bfhi(ow.y), bflo(ow.z), bfhi(ow.z), bflo(ow.w), bfhi(ow.w)};
#pragma unroll
          for (int j = 0; j < 4; ++j) { o[j] = o[j] * rs * g0[j] * v0[j] * sigmoidf_(v0[j]); o[4 + j] = o[4 + j] * rs * g1[j] * v1[j] * sigmoidf_(v1[j]); }
          u32x4 w; w.x = pk(o[0], o[1]); w.y = pk(o[2], o[3]); w.z = pk(o[4], o[5]); w.w = pk(o[6], o[7]);
          gst<u32x4>(op, w);
        }
    }
  } else if (epi == EPI_GLU) {
    const int ca = 128 * (bcol >> 8) + wc * 32 + 8 * fq;
    const f32x4 ba0 = gld<f32x4>(g.bias + ca), ba1 = gld<f32x4>(g.bias + ca + 4);
    const f32x4 bg0 = gld<f32x4>(g.bias + 1024 + ca), bg1 = gld<f32x4>(g.bias + 1024 + ca + 4);
#pragma unroll
    for (int ai = 0; ai < 2; ++ai)
#pragma unroll
      for (int m = 0; m < 4; ++m) {
        const int row = rowb + ai * HALF + m * 16;
        const float ru = gld<float>(g.rowscale + row);
        const f32x4 a0 = acc[ai][0][m][0] * ru + ba0, a1 = acc[ai][0][m][1] * ru + ba1, t0 = acc[ai][1][m][0] * ru + bg0, t1 = acc[ai][1][m][1] * ru + bg1;
        float o[8];
#pragma unroll
        for (int j = 0; j < 4; ++j) { o[j] = a0[j] * sigmoidf_(t0[j]); o[4 + j] = a1[j] * sigmoidf_(t1[j]); }
        u32x4 w; w.x = pk(o[0], o[1]); w.y = pk(o[2], o[3]); w.z = pk(o[4], o[5]); w.w = pk(o[6], o[7]);
        gst<u32x4>(g.o0 + (size_t)row * 1024 + ca, w);
      }
  } else {
#pragma unroll
    for (int bj = 0; bj < 2; ++bj) {
      const int col = colb + bj * HALF;
#pragma unroll
      for (int ai = 0; ai < 2; ++ai)
#pragma unroll
        for (int m = 0; m < 4; ++m) {
          const int row = rowb + ai * HALF + m * 16;
          const float ru = gld<float>(g.rowscale + row);
          f32x4 v0 = acc[ai][bj][m][0] * ru, v1 = acc[ai][bj][m][1] * ru;
          if (bcol < 2048) {
            if (bcol < 512) { v0 = v0 * 0.08838834764831845f; v1 = v1 * 0.08838834764831845f; }
            bf16_t* base = (bcol < 1024) ? (g.o0 + (size_t)row * 1024 + col) : (g.o1 + (size_t)row * 1024 + (col - 1024));
            u32x4 w; w.x = pk(v0[0], v0[1]); w.y = pk(v0[2], v0[3]); w.z = pk(v1[0], v1[1]); w.w = pk(v1[2], v1[3]);
            gst<u32x4>(base, w);
          } else if (col < 2080) {
            gst<f32x4>(g.f0 + (size_t)row * 32 + (col - 2048), v0); gst<f32x4>(g.f0 + (size_t)row * 32 + (col - 2048) + 4, v1);
          }
        }
    }
  }
}

DI int perm32(int rho) { const int n = rho >> 4, i = rho & 15; return 8 * (i >> 2) + 4 * n + (i & 3); }
DI bool tile_next(int i, int G, int c, int nM, int nN, int& pm, int& pn) {
  const int nwg = nM * nN; const long L = (long)i * G + c; if (L >= nwg) return false;
  int wgid = (int)L; { const int q = nwg / NXCD, r = nwg % NXCD, xcd = wgid % NXCD, off = wgid / NXCD; wgid = (xcd < r ? xcd * (q + 1) : r * (q + 1) + (xcd - r) * q) + off; }
  const int nig = WGM * nN, gid = wgid / nig, fm = gid * WGM, gsz = (nM - fm) < WGM ? (nM - fm) : WGM;
  pm = fm + ((wgid % nig) % gsz); pn = (wgid % nig) / gsz; return true;
}
DI void gemm_phase(const GemmDesc& g, LAS unsigned char* lds) {
  constexpr int HTB = HALF * BK * 2;
  const int tid = otid(), wid = __builtin_amdgcn_readfirstlane(tid >> 6), lane = tid & 63, wr = wid >> 2, wc = wid & 3, fr = lane & 15, fq = lane >> 4;
  const int K = g.K, nt = K / BK, nM = T_ / BM, nN = g.N / BM, G = gridDim.x, cb = blockIdx.x;
  unsigned voffA[2], voffB[2];
#pragma unroll
  for (int i = 0; i < 2; ++i) { int R, C; stage_rc(tid * 16 + i * 8192, R, C); const int Rb = (R & ~31) + perm32(R & 31);
    voffA[i] = (unsigned)(R * K + C) * 2u; voffB[i] = (unsigned)(Rb * K + C) * 2u; }
  const size_t kstep = (size_t)(BK * 2), hstep = (size_t)HALF * K * 2, tstep = 2 * hstep;
  const unsigned ldsw = (unsigned)wid * 1024u;
  const int aoff = lds_byte(wr * 64 + fr, fq * 8), boff = lds_byte(wc * 32 + fr, fq * 8);
#define PG8_SA(b, h) (((b) * 2 + (h)) * HTB)
#define PG8_SB(b, h) ((4 + (b) * 2 + (h)) * HTB)
#define PG8_STAGE(bufoff, gbase, voff) do { _Pragma("unroll") for (int _i = 0; _i < 2; ++_i) \
    __builtin_amdgcn_global_load_lds((const unsigned*)((const char*)(gbase) + (voff)[_i]), (LAS unsigned*)(lds + (bufoff) + ldsw + _i * 8192), 16, 0, 0); } while (0)
#define PG8_LDA(dst, b, h) do { _Pragma("unroll") for (int m = 0; m < 4; ++m) _Pragma("unroll") for (int k = 0; k < 2; ++k) dst[m][k] = *(const LAS bf16x8*)(lds + PG8_SA(b, h) + aoff + m * 2048 + k * 1024); } while (0)
#define PG8_LDB(dst, b, h) do { _Pragma("unroll") for (int n = 0; n < 2; ++n) _Pragma("unroll") for (int k = 0; k < 2; ++k) dst[n][k] = *(const LAS bf16x8*)(lds + PG8_SB(b, h) + boff + n * 2048 + k * 1024); } while (0)
#define PG8_MMA(ai, bj, At, Bt) do { __builtin_amdgcn_s_setprio(1); _Pragma("unroll") for (int m = 0; m < 4; ++m) _Pragma("unroll") for (int n = 0; n < 2; ++n) _Pragma("unroll") for (int k = 0; k < 2; ++k) \
    acc[ai][bj][m][n] = __builtin_amdgcn_mfma_f32_16x16x32_bf16(Bt[n][k], At[m][k], acc[ai][bj][m][n], 0, 0, 0); __builtin_amdgcn_s_setprio(0); } while (0)
#define PG8_WAIT_V(n) asm volatile("s_waitcnt vmcnt(" #n ")" ::: "memory")
#define PG8_WAIT_L(n) asm volatile("s_waitcnt lgkmcnt(" #n ")" ::: "memory")
#define PG8_BAR __builtin_amdgcn_s_barrier()
#define PG8_SCHED __builtin_amdgcn_sched_barrier(0)
  int cpm, cpn, npm = 0, npn = 0, ui = 0;
  if (!tile_next(0, G, cb, nM, nN, cpm, cpn)) return;
  f32x4 acc[2][2][4][2];
#pragma unroll
  for (int a = 0; a < 2; ++a)
#pragma unroll
    for (int b = 0; b < 2; ++b)
#pragma unroll
      for (int m = 0; m < 4; ++m)
#pragma unroll
        for (int n = 0; n < 2; ++n) acc[a][b][m][n] = (f32x4){0.f, 0.f, 0.f, 0.f};
  bf16x8 At[4][2], B0[2][2], B1[2][2];
  const char* cA = (const char*)g.A + (size_t)cpm * tstep; const char* cB = (const char*)g.Bt + (size_t)cpn * tstep;
  PG8_STAGE(PG8_SB(0, 0), cB, voffB); PG8_STAGE(PG8_SB(0, 1), cB + hstep, voffB); PG8_STAGE(PG8_SA(0, 0), cA, voffA); PG8_STAGE(PG8_SA(0, 1), cA + hstep, voffA);
  if (wr == 1) PG8_BAR;
  PG8_WAIT_V(2); PG8_BAR;
  PG8_STAGE(PG8_SB(1, 0), cB + kstep, voffB); PG8_STAGE(PG8_SA(1, 0), cA + kstep, voffA); PG8_STAGE(PG8_SB(1, 1), cB + hstep + kstep, voffB);
  PG8_WAIT_V(6); PG8_BAR;
  for (;;) {
    const bool has_next = tile_next(ui + 1, G, cb, nM, nN, npm, npn);
    const char* nA = has_next ? (const char*)g.A + (size_t)npm * tstep : cA; const char* nB = has_next ? (const char*)g.Bt + (size_t)npn * tstep : cB;
    for (int t = 0; t < nt; t += 2) {
      const bool last = (t == nt - 2);
      const char* a1 = cA + (size_t)(t + 1) * kstep;
      const char* a2 = last ? nA : cA + (size_t)(t + 2) * kstep; const char* b2 = last ? nB : cB + (size_t)(t + 2) * kstep;
      const char* a3 = a2 + kstep; const char* b3 = b2 + kstep;
      PG8_LDB(B0, 0, 0); PG8_LDB(B1, 0, 1); PG8_SCHED; PG8_LDA(At, 0, 0); PG8_STAGE(PG8_SA(1, 1), a1 + hstep, voffA);
      PG8_WAIT_V(8); PG8_WAIT_L(0); PG8_BAR; PG8_MMA(0, 0, At, B0); PG8_MMA(0, 1, At, B1); PG8_BAR; PG8_SCHED;
      PG8_LDA(At, 0, 1); PG8_STAGE(PG8_SB(0, 0), b2, voffB); PG8_STAGE(PG8_SB(0, 1), b2 + hstep, voffB); PG8_STAGE(PG8_SA(0, 0), a2, voffA);
      PG8_WAIT_V(8); PG8_WAIT_L(0); PG8_BAR; PG8_MMA(1, 0, At, B0); PG8_MMA(1, 1, At, B1); PG8_BAR; PG8_SCHED;
      PG8_LDB(B0, 1, 0); PG8_LDB(B1, 1, 1); PG8_SCHED; PG8_LDA(At, 1, 0); PG8_STAGE(PG8_SA(0, 1), a2 + hstep, voffA);
      PG8_WAIT_V(8); PG8_WAIT_L(0); PG8_BAR; PG8_MMA(0, 0, At, B0); PG8_MMA(0, 1, At, B1); PG8_BAR; PG8_SCHED;
      PG8_LDA(At, 1, 1); PG8_STAGE(PG8_SB(1, 0), b3, voffB); PG8_STAGE(PG8_SB(1, 1), b3 + hstep, voffB); PG8_STAGE(PG8_SA(1, 0), a3, voffA);
      PG8_WAIT_V(8); PG8_WAIT_L(0); PG8_BAR; PG8_MMA(1, 0, At, B0); PG8_MMA(1, 1, At, B1); PG8_BAR; PG8_SCHED;
    }
    if (wr == 0) PG8_BAR;
    gemm_epilogue(g, acc, cpm * BM, cpn * BM, wr, wc, fr, fq);
    if (!has_next) break;
#pragma unroll
    for (int a = 0; a < 2; ++a)
#pragma unroll
      for (int b = 0; b < 2; ++b)
#pragma unroll
        for (int m = 0; m < 4; ++m)
#pragma unroll
          for (int n = 0; n < 2; ++n) acc[a][b][m][n] = (f32x4){0.f, 0.f, 0.f, 0.f};
    cpm = npm; cpn = npn; cA = nA; cB = nB; ++ui;
    if (wr == 1) PG8_BAR;
  }
  PG8_WAIT_V(0);
  PG8_BAR;
}

template <int R> DI void conv_row(f32x2 (&acc)[32], const f32x2 (&wt)[31], const unsigned* tile, int tid) {
  const unsigned x = tile[R * 512 + tid];
  const f32x2 xv = {bflo(x), bfhi(x)};
#pragma unroll
  for (int i = 0; i < 32; ++i) { if (R - i >= 0 && R - i < 31) acc[i] = acc[i] + xv * wt[(R - i >= 0 && R - i < 31) ? R - i : 0]; }
  if ((R & 7) == 7) asm volatile("" ::: "memory");
}
template <int R0, int N> struct ConvRows {
  static DI void run(f32x2 (&acc)[32], const f32x2 (&wt)[31], const unsigned* tile, int tid) { conv_row<R0>(acc, wt, tile, tid); ConvRows<R0 + 1, N - 1>::run(acc, wt, tile, tid); }
};
template <int R0> struct ConvRows<R0, 0> { static DI void run(f32x2 (&)[32], const f32x2 (&)[31], const unsigned*, int) {} };
DI void conv_phase(const bf16_t* hc, bf16_t* hn, char* lds) {
  const float* wdw = KP(conv_w_dw);
  const int tid = otid();
  unsigned* tile = (unsigned*)lds;
  float* red = (float*)lds;
  unsigned toff = 131072; asm volatile("" : "+s"(toff));
  float* tot = (float*)(lds + toff);
  const f32x2 bdw = gld<f32x2>(KP(conv_b_dw) + 2 * tid);
  const f32x2 lg = gld<f32x2>(KP(conv_ln_g) + 2 * tid), lb = gld<f32x2>(KP(conv_ln_b) + 2 * tid);
  for (int item = blockIdx.x; item < T_ / 32; item += gridDim.x) {
    const int b = item >> 8, t0 = (item & 255) * 32;
    __syncthreads();
#pragma unroll
    for (int hf = 0; hf < 2; ++hf) {
      u32x4 w[8];
#pragma unroll
      for (int i = 0; i < 8; ++i) {
        const int c = tid + 512 * (8 * hf + i), r = c >> 7, ch = c & 127, t = t0 - 15 + r;
        w[i] = (u32x4){0u, 0u, 0u, 0u};
        if (r < 62 && t >= 0 && t < L_) w[i] = gld<u32x4>(hc + ((size_t)(b * L_ + t)) * 1024 + ch * 8);
      }
#pragma unroll
      for (int i = 0; i < 8; ++i) {
        const int c = tid + 512 * (8 * hf + i), r = c >> 7, ch = c & 127;
        if (r < 62) *(u32x4*)(tile + r * 512 + ch * 4) = w[i];
      }
      asm volatile("" ::: "memory");
    }
    __syncthreads();
    const float* wd2 = wdw; asm volatile("" : "+s"(wd2));
    f32x2 acc[32], wt[31];
#pragma unroll
    for (int i = 0; i < 32; ++i) acc[i] = bdw;
#pragma unroll
    for (int j = 0; j < 31; ++j) wt[j] = gld<f32x2>(wd2 + j * 1024 + 2 * tid);
    ConvRows<0, 62>::run(acc, wt, tile, tid);
    __syncthreads();
#pragma unroll
    for (int i = 0; i < 32; ++i) { red[i * 512 + tid] = acc[i].x + acc[i].y; red[(32 + i) * 512 + tid] = acc[i].x * acc[i].x + acc[i].y * acc[i].y; }
    __syncthreads();
    {
      const int q = tid >> 3, part = tid & 7;
      float sm = 0.f;
#pragma unroll
      for (int i = 0; i < 16; ++i) { f32x4 v = *(const f32x4*)(red + q * 512 + part * 64 + i * 4); sm += (v[0] + v[1]) + (v[2] + v[3]); }
      sm += __shfl_xor(sm, 1); sm += __shfl_xor(sm, 2); sm += __shfl_xor(sm, 4);
      if (part == 0) tot[q] = sm;
    }
    __syncthreads();
#pragma unroll
    for (int i = 0; i < 32; ++i) {
      const float mu = tot[i] * (1.0f / 1024.0f), var = fmaxf(tot[32 + i] * (1.0f / 1024.0f) - mu * mu, 0.f), rstd = rsqrtf(var + EPS);
      float y0 = (acc[i].x - mu) * rstd * lg.x + lb.x, y1 = (acc[i].y - mu) * rstd * lg.y + lb.y;
      y0 = y0 * sigmoidf_(y0); y1 = y1 * sigmoidf_(y1);
      gst<unsigned>(hn + ((size_t)(b * L_ + t0 + i)) * 1024 + 2 * tid, pk(y0, y1));
    }
  }
}

DI void glaprep_phase(const bf16_t* qk, const float* t1, bf16_t* QKf, bf16_t* QKb, float* E, char* lds) {
  const int tid = otid();
  float* t1s = (float*)lds;
  bf16_t* raw = (bf16_t*)(lds + 8192);
  float w2f[16], w2b[16];
  const float* gw2 = KP(gla_w2); const float* ggb = KP(gla_gb);
#pragma unroll
  for (int r = 0; r < 16; ++r) { w2f[r] = gld<float>(gw2 + r * 512 + tid); w2b[r] = gld<float>(gw2 + (16 + r) * 512 + tid); }
  const float bf_ = gld<float>(ggb + tid), bb_ = gld<float>(ggb + 512 + tid);
  for (int item = blockIdx.x; item < T_ / 64; item += gridDim.x) {
    const size_t tok0 = (size_t)item * 64;
    __syncthreads();
    {
      u32x4 w[16];
#pragma unroll
      for (int i = 0; i < 16; ++i) w[i] = gld<u32x4>(qk + tok0 * 1024 + (size_t)(tid + 512 * i) * 8);
      const f32x4 tv = gld<f32x4>(t1 + tok0 * 32 + tid * 4);
#pragma unroll
      for (int i = 0; i < 16; ++i) *(u32x4*)(raw + (size_t)(tid + 512 * i) * 8) = w[i];
      *(f32x4*)(t1s + tid * 4) = tv;
    }
    __syncthreads();
    float c = 0.f;
#pragma unroll 8
    for (int i = 0; i < 64; ++i) {
      float lgt = bf_;
#pragma unroll
      for (int r = 0; r < 16; ++r) lgt += t1s[i * 32 + r] * w2f[r];
      c += log_sigmoid_(lgt) * (1.0f / 16.0f);
      const float qv = bf1(raw[i * 1024 + tid]), kv = bf1(raw[i * 1024 + 512 + tid]);
      gst<bf16_t>(QKf + (tok0 + i) * 1024 + tid, tobf(qv * __expf(c)));
      gst<bf16_t>(QKf + (tok0 + i) * 1024 + 512 + tid, tobf(kv * __expf(-c)));
    }
    gst<float>(E + (size_t)item * 512 + tid, __expf(c));
    c = 0.f;
#pragma unroll 8
    for (int i = 63; i >= 0; --i) {
      float lgt = bb_;
#pragma unroll
      for (int r = 0; r < 16; ++r) lgt += t1s[i * 32 + 16 + r] * w2b[r];
      c += log_sigmoid_(lgt) * (1.0f / 16.0f);
      const float qv = bf1(raw[i * 1024 + tid]), kv = bf1(raw[i * 1024 + 512 + tid]);
      gst<bf16_t>(QKb + (tok0 + i) * 1024 + tid, tobf(qv * __expf(c)));
      gst<bf16_t>(QKb + (tok0 + i) * 1024 + 512 + tid, tobf(kv * __expf(-c)));
    }
    gst<float>(E + (size_t)(T_ / 64) * 512 + (size_t)item * 512 + tid, __expf(c));
  }
}

template <int DK, bool GLA>
DI void ppass_phase(const bf16_t* Qf, const bf16_t* Kf, const bf16_t* Qb, const bf16_t* Kb, int ld, const float* decay, bf16_t* P) {
  const int tid_ = otid(), wid = tid_ >> 6, lane = tid_ & 63, fr = lane & 15, fq = lane >> 4;
  const int rt = wid >> 1, ct0 = 2 * (wid & 1);
  for (int item = blockIdx.x; item < 2048; item += gridDim.x) {
    const int n = item & 127, h = (item >> 7) & 3, b = item >> 9;
    const size_t tok0 = (size_t)b * L_ + n * 64;
    f32x4 xf[2] = {}, xb[2] = {};
    const bf16_t* qa = Qf + (tok0 + 16 * rt + fr) * ld + h * DK + 8 * fq;
    const bf16_t* ka0 = Kf + (tok0 + 16 * ct0 + fr) * ld + h * DK + 8 * fq;
    const bf16_t* ka1 = ka0 + (size_t)16 * ld;
#pragma unroll
    for (int kk = 0; kk < DK / 32; ++kk) {
      const bf16x8 a = gld<bf16x8>(qa + 32 * kk), b0 = gld<bf16x8>(ka0 + 32 * kk), b1 = gld<bf16x8>(ka1 + 32 * kk);
      xf[0] = __builtin_amdgcn_mfma_f32_16x16x32_bf16(a, b0, xf[0], 0, 0, 0);
      xf[1] = __builtin_amdgcn_mfma_f32_16x16x32_bf16(a, b1, xf[1], 0, 0, 0);
    }
    if (GLA) {
      const bf16_t* qb = Qb + (tok0 + 16 * rt + fr) * ld + h * DK + 8 * fq;
      const bf16_t* kb0 = Kb + (tok0 + 16 * ct0 + fr) * ld + h * DK + 8 * fq;
      const bf16_t* kb1 = kb0 + (size_t)16 * ld;
#pragma unroll
      for (int kk = 0; kk < DK / 32; ++kk) {
        const bf16x8 a = gld<bf16x8>(qb + 32 * kk), b0 = gld<bf16x8>(kb0 + 32 * kk), b1 = gld<bf16x8>(kb1 + 32 * kk);
        xb[0] = __builtin_amdgcn_mfma_f32_16x16x32_bf16(a, b0, xb[0], 0, 0, 0);
        xb[1] = __builtin_amdgcn_mfma_f32_16x16x32_bf16(a, b1, xb[1], 0, 0, 0);
      }
    }
    bf16_t* Po = P + (size_t)item * 4096;
    Po = P + ((size_t)((b * 128 + n) * 4 + h)) * 4096;
#pragma unroll
    for (int c = 0; c < 2; ++c)
#pragma unroll
      for (int j = 0; j < 4; ++j) {
        const int i = 16 * rt + 4 * fq + j, s = 16 * (ct0 + c) + fr;
        float v;
        if (GLA) v = (s <= i) ? xf[c][j] : xb[c][j];
        else v = xf[c][j];
        gst<bf16_t>(Po + i * 64 + s, tobf(v));
      }
  }
}

struct FalseC { static constexpr bool value = false; }; struct TrueC { static constexpr bool value = true; };
struct ScanArgs {
  const bf16_t* q0; const bf16_t* q1; const bf16_t* k0; const bf16_t* k1;
  const bf16_t* v; const bf16_t* P; bf16_t* o;
  const float* E;
  const float* decay;
  float* ssp;
};
DI s16x4 tr_read(unsigned a) { s16x4 r; asm volatile("ds_read_b64_tr_b16 %0, %1\n\ts_waitcnt lgkmcnt(0)" : "=&v"(r) : "v"(a) : "memory"); return r; }
template <int SA_, int SB_>
DI void tr_read8(unsigned a, s16x4 (&r)[8]) {
  asm volatile("ds_read_b64_tr_b16 %0, %8 offset:%9\n\tds_read_b64_tr_b16 %1, %8 offset:%10\n\tds_read_b64_tr_b16 %2, %8 offset:%11\n\tds_read_b64_tr_b16 %3, %8 offset:%12\n\t"
               "ds_read_b64_tr_b16 %4, %8 offset:%13\n\tds_read_b64_tr_b16 %5, %8 offset:%14\n\tds_read_b64_tr_b16 %6, %8 offset:%15\n\tds_read_b64_tr_b16 %7, %8 offset:%16\n\t"
               "s_waitcnt lgkmcnt(0)"
               : "=&v"(r[0]), "=&v"(r[1]), "=&v"(r[2]), "=&v"(r[3]), "=&v"(r[4]), "=&v"(r[5]), "=&v"(r[6]), "=&v"(r[7])
               : "v"(a), "n"(0), "n"(SA_), "n"(SB_), "n"(SB_ + SA_), "n"(2 * SB_), "n"(2 * SB_ + SA_), "n"(3 * SB_), "n"(3 * SB_ + SA_)
               : "memory");
}
template <int SA_, int SB_>
DI void tr_issue8(unsigned a, s16x4 (&r)[8]) {
  asm volatile("ds_read_b64_tr_b16 %0, %8 offset:%9\n\tds_read_b64_tr_b16 %1, %8 offset:%10\n\tds_read_b64_tr_b16 %2, %8 offset:%11\n\tds_read_b64_tr_b16 %3, %8 offset:%12\n\t"
               "ds_read_b64_tr_b16 %4, %8 offset:%13\n\tds_read_b64_tr_b16 %5, %8 offset:%14\n\tds_read_b64_tr_b16 %6, %8 offset:%15\n\tds_read_b64_tr_b16 %7, %8 offset:%16"
               : "=&v"(r[0]), "=&v"(r[1]), "=&v"(r[2]), "=&v"(r[3]), "=&v"(r[4]), "=&v"(r[5]), "=&v"(r[6]), "=&v"(r[7])
               : "v"(a), "n"(0), "n"(SA_), "n"(SB_), "n"(SB_ + SA_), "n"(2 * SB_), "n"(2 * SB_ + SA_), "n"(3 * SB_), "n"(3 * SB_ + SA_)
               : "memory");
}
DI void tr_wait8(s16x4 (&a)[8]) {
  asm volatile("s_waitcnt lgkmcnt(0)" : "+v"(a[0]), "+v"(a[1]), "+v"(a[2]), "+v"(a[3]), "+v"(a[4]), "+v"(a[5]), "+v"(a[6]), "+v"(a[7]) :: "memory");
}
DI void tr_wait16(s16x4 (&a)[8], s16x4 (&b)[8]) {
  asm volatile("s_waitcnt lgkmcnt(0)" : "+v"(a[0]), "+v"(a[1]), "+v"(a[2]), "+v"(a[3]), "+v"(a[4]), "+v"(a[5]), "+v"(a[6]), "+v"(a[7]),
               "+v"(b[0]), "+v"(b[1]), "+v"(b[2]), "+v"(b[3]), "+v"(b[4]), "+v"(b[5]), "+v"(b[6]), "+v"(b[7]) :: "memory");
}
DI bf16x8 cat8(s16x4 a, s16x4 b) { bf16x8 r; r[0] = a[0]; r[1] = a[1]; r[2] = a[2]; r[3] = a[3]; r[4] = b[0]; r[5] = b[1]; r[6] = b[2]; r[7] = b[3]; return r; }
DI u32x4 scale8(u32x4 w, float s) {
  u32x4 r; r.x = pk(bflo(w.x) * s, bfhi(w.x) * s); r.y = pk(bflo(w.y) * s, bfhi(w.y) * s); r.z = pk(bflo(w.z) * s, bfhi(w.z) * s); r.w = pk(bflo(w.w) * s, bfhi(w.w) * s); return r;
}
template <int DK>
DI void scan_phase(const ScanArgs& a, char* lds, const XcdBarrier& xb) {
  constexpr int QS = DK * 2 + 16, KS = DK * 2 + 64, VS = 192, PS = 144, NQ = DK / 128 * 2;
  constexpr int RW = DK / 4, NT = RW / 32;
  constexpr int LDQK = (DK == 256) ? 2048 : 1024, LDV = LDQK, LDO = LDQK, DVH = 2 * DK;
  constexpr bool ret = (DK == 256);
  constexpr int OFF_K = 64 * QS, OFF_V = OFF_K + 64 * KS, OFF_PP = OFF_V + 64 * VS, OFF_O = OFF_PP + 64 * PS, OFF_EE = OFF_O + 65536, OFF_SC = OFF_EE + DK * 4;
  static_assert(OFF_SC + 512 <= (int)LDS_BYTES - 16, "LDS budget");
  const int tid = otid(), wid = tid >> 6, lane = tid & 63, wr = __builtin_amdgcn_readfirstlane(wid >> 1), wc = __builtin_amdgcn_readfirstlane(wid & 1);
  const int r = lane & 31, hh = lane >> 5, g1 = (lane >> 4) & 1, i16 = lane & 15, qd = i16 >> 2, pp = i16 & 3;
  const unsigned ldsb = (unsigned)(uintptr_t)lds;
  float* qsc = (float*)(lds + OFF_SC); float* ksc = qsc + 64;
  constexpr int NS = DVH >> 6, nitems = 32 * NS;
  const int bid = obid(), xcd = bid & 7, inx = bid >> 3;
  const bool g256 = (gridDim.x == 256);
  const bool active = g256 ? (inx < 4 * NS) : (bid < nitems);
  const int item = g256 ? ((xcd * 4 + inx / NS) * NS + inx % NS) : bid;
  const int slice = item % NS, dir = (item / NS) & 1, h = (item / (2 * NS)) & 3, b = item / (8 * NS);
  float econst = 1.f;
  if (active && ret) {
    const float lg = log_sigmoid_(gld<float>(a.decay + dir * 4 + h));
    econst = __expf(64.f * lg);
    if (tid < 64) { const float e = dir ? (float)(64 - tid) : (float)(tid + 1); qsc[tid] = __expf(lg * e); ksc[tid] = __expf(-lg * e); }
  }
  __syncthreads();
  const bf16_t* qg = (dir ? a.q1 : a.q0) + (size_t)b * L_ * LDQK + h * DK;
  const bf16_t* kg = (dir ? a.k1 : a.k0) + (size_t)b * L_ * LDQK + h * DK;
  const bf16_t* vg = a.v + (size_t)b * L_ * LDV + h * DVH + slice * 64;
  bf16_t* og = a.o + (size_t)b * L_ * LDO + h * DVH + slice * 64;
  const bf16_t* pg = a.P + ((size_t)(b * 128) * 4 + h) * 4096;
  const float* eg = ret ? nullptr : (a.E + (size_t)dir * (T_ / 64) * (4 * DK) + (size_t)(b * 128) * (4 * DK) + h * DK);
  f32x16 S[NT];
#pragma unroll
  for (int j = 0; j < NT; ++j)
#pragma unroll
    for (int e = 0; e < 16; ++e) S[j][e] = 0.f;
  struct Regs { u32x4 q[NQ], k[NQ], v, p; };
  Regs RA, RB;
  constexpr int DEPTH = (DK == 128) ? 2 : 1;
  float enext = 1.f;
  const int vrow = tid >> 3, vch = tid & 7;
  auto chunk_of = [&](int st) { const int s2 = st < 128 ? st : 127; return dir ? 127 - s2 : s2; };
  auto issue = [&](Regs& R, int n) {
    const size_t t0 = (size_t)n * 64;
#pragma unroll
    for (int i = 0; i < NQ; ++i) {
      const int c = tid + 512 * i, row = c / (DK / 8), ch = c % (DK / 8);
      R.q[i] = gld<u32x4>(qg + (t0 + row) * LDQK + ch * 8);
      R.k[i] = gld<u32x4>(kg + (t0 + row) * LDQK + ch * 8);
    }
    R.v = gld<u32x4>(vg + (t0 + vrow) * LDV + vch * 8);
    R.p = gld<u32x4>(pg + (size_t)n * 4 * 4096 + vrow * 64 + vch * 8);
  };
  auto issue1 = [&](int n1) { if (!ret) enext = gld<float>(eg + (size_t)n1 * (4 * DK) + (tid < DK ? tid : 0)); };
  auto step_fn = [&](Regs& R, int step, auto second_c) {
    constexpr bool second = decltype(second_c)::value;
    const int n = dir ? 127 - step : step;
    u32x4 ocur = {0u, 0u, 0u, 0u};
    if (second) ocur = gld<u32x4>(og + ((size_t)n * 64 + vrow) * LDO + vch * 8);
#pragma unroll
    for (int i = 0; i < NQ; ++i) {
      const int c = tid + 512 * i, row = c / (DK / 8), ch = c % (DK / 8);
      *(u32x4*)(lds + row * QS + ch * 16) = R.q[i];
      *(u32x4*)(lds + OFF_K + row * KS + ch * 16) = R.k[i];
    }
    *(u32x4*)(lds + OFF_V + vrow * VS + vch * 16) = ret ? scale8(R.v, ksc[vrow]) : R.v;
    {
      u32x4 w = R.p; unsigned ww[4] = {w.x, w.y, w.z, w.w};
#pragma unroll
      for (int e = 0; e < 4; ++e) {
        const int s0 = vch * 8 + 2 * e, s1 = s0 + 1;
        const bool k0 = dir ? (s0 > vrow) : (s0 <= vrow), k1 = dir ? (s1 > vrow) : (s1 <= vrow);
        ww[e] = (k0 ? (ww[e] & 0xffffu) : 0u) | (k1 ? (ww[e] & 0xffff0000u) : 0u);
      }
      *(u32x4*)(lds + OFF_PP + vrow * PS + vch * 16) = (u32x4){ww[0], ww[1], ww[2], ww[3]};
    }
    if (!ret) { if (tid < DK) *(float*)(lds + OFF_EE + tid * 4) = enext; }
    lds_barrier();
    issue(R, chunk_of(step + DEPTH));
    issue1(chunk_of(step + 1));
    bf16x8 vf[4];
    bf16x8 qa[2][2];
    auto ldq = [&](int jk, bf16x8 (&dst)[2]) {
      const int j = jk >> 1, ks = jk & 1;
#pragma unroll
      for (int tt = 0; tt < 2; ++tt) {
        const char* qp = lds + (32 * tt + r) * QS + (wr * RW + 32 * j + 16 * ks + 4 * hh) * 2;
        dst[tt] = cat8(*(const s16x4*)qp, *(const s16x4*)(qp + 16));
      }
    };
    f32x16 oacc[2];
    const f32x16 zero16 = {0.f, 0.f, 0.f, 0.f, 0.f, 0.f, 0.f, 0.f, 0.f, 0.f, 0.f, 0.f, 0.f, 0.f, 0.f, 0.f};
    {
      s16x4 t8[8];
      tr_issue8<4 * VS, 16 * VS>(ldsb + OFF_V + (8 * hh + qd) * VS + (32 * wc + 16 * g1 + 4 * pp) * 2, t8);
      const bf16x8 pa0 = *(const bf16x8*)(lds + OFF_PP + r * PS + (16 * wr + 8 * hh) * 2);
      const bf16x8 pa1 = *(const bf16x8*)(lds + OFF_PP + (32 + r) * PS + (16 * wr + 8 * hh) * 2);
      ldq(0, qa[0]);
      tr_wait8(t8);
#pragma unroll
      for (int s4 = 0; s4 < 4; ++s4) vf[s4] = cat8(t8[2 * s4], t8[2 * s4 + 1]);
      if (wr == 0) { oacc[0] = __builtin_amdgcn_mfma_f32_32x32x16_bf16(pa0, vf[0], zero16, 0, 0, 0); oacc[1] = __builtin_amdgcn_mfma_f32_32x32x16_bf16(pa1, vf[0], zero16, 0, 0, 0); }
      else if (wr == 1) { oacc[0] = __builtin_amdgcn_mfma_f32_32x32x16_bf16(pa0, vf[1], zero16, 0, 0, 0); oacc[1] = __builtin_amdgcn_mfma_f32_32x32x16_bf16(pa1, vf[1], zero16, 0, 0, 0); }
      else if (wr == 2) { oacc[0] = __builtin_amdgcn_mfma_f32_32x32x16_bf16(pa0, vf[2], zero16, 0, 0, 0); oacc[1] = __builtin_amdgcn_mfma_f32_32x32x16_bf16(pa1, vf[2], zero16, 0, 0, 0); }
      else { oacc[0] = __builtin_amdgcn_mfma_f32_32x32x16_bf16(pa0, vf[3], zero16, 0, 0, 0); oacc[1] = __builtin_amdgcn_mfma_f32_32x32x16_bf16(pa1, vf[3], zero16, 0, 0, 0); }
    }
#pragma unroll
    for (int jk = 0; jk < 2 * NT; ++jk) {
      if (jk + 1 < 2 * NT) ldq(jk + 1, qa[(jk + 1) & 1]);
      __builtin_amdgcn_sched_barrier(0);
      const int j = jk >> 1, ks = jk & 1;
      u32x4 sb;
      sb.x = pk(S[j][8 * ks + 0], S[j][8 * ks + 1]); sb.y = pk(S[j][8 * ks + 2], S[j][8 * ks + 3]);
      sb.z = pk(S[j][8 * ks + 4], S[j][8 * ks + 5]); sb.w = pk(S[j][8 * ks + 6], S[j][8 * ks + 7]);
      const bf16x8 bfr = __builtin_bit_cast(bf16x8, sb);
      oacc[0] = __builtin_amdgcn_mfma_f32_32x32x16_bf16(qa[jk & 1][0], bfr, oacc[0], 0, 0, 0);
      oacc[1] = __builtin_amdgcn_mfma_f32_32x32x16_bf16(qa[jk & 1][1], bfr, oacc[1], 0, 0, 0);
      __builtin_amdgcn_sched_barrier(0);
    }
#pragma unroll
    for (int tt = 0; tt < 2; ++tt)
#pragma unroll
      for (int e = 0; e < 16; ++e) {
        const int t = 32 * tt + (e & 3) + 8 * (e >> 2) + 4 * hh;
        *(float*)(lds + OFF_O + ((wr * 64 + t) * 64 + 32 * wc + r) * 4) = oacc[tt][e];
      }
    {
      s16x4 ka[8], kb[8];
      tr_issue8<4 * KS, 16 * KS>(ldsb + OFF_K + (8 * hh + qd) * KS + (wr * RW + 16 * g1 + 4 * pp) * 2, ka);
      if (NT == 2) tr_issue8<4 * KS, 16 * KS>(ldsb + OFF_K + (8 * hh + qd) * KS + (wr * RW + 32 + 16 * g1 + 4 * pp) * 2, kb);
      if (NT == 2) tr_wait16(ka, kb); else tr_wait8(ka);
#pragma unroll
      for (int s4 = 0; s4 < 4; ++s4) {
        S[0] = __builtin_amdgcn_mfma_f32_32x32x16_bf16(cat8(ka[2 * s4], ka[2 * s4 + 1]), vf[s4], S[0], 0, 0, 0);
        if (NT == 2) S[NT - 1] = __builtin_amdgcn_mfma_f32_32x32x16_bf16(cat8(kb[2 * s4], kb[2 * s4 + 1]), vf[s4], S[NT - 1], 0, 0, 0);
      }
    }
#pragma unroll
    for (int j = 0; j < NT; ++j) {
      if (ret) {
#pragma unroll
        for (int e = 0; e < 16; ++e) S[j][e] *= econst;
      } else {
#pragma unroll
        for (int gq = 0; gq < 4; ++gq) {
          const f32x4 ev = *(const f32x4*)(lds + OFF_EE + (wr * RW + 32 * j + 8 * gq + 4 * hh) * 4);
#pragma unroll
          for (int e = 0; e < 4; ++e) S[j][4 * gq + e] *= ev[e];
        }
      }
    }
    lds_barrier();
    {
      float sum[8];
#pragma unroll
      for (int e = 0; e < 8; ++e) sum[e] = 0.f;
#pragma unroll
      for (int w4 = 0; w4 < 4; ++w4) {
        const float* op = (const float*)(lds + OFF_O + ((w4 * 64 + vrow) * 64 + vch * 8) * 4);
        const f32x4 x0 = *(const f32x4*)op, x1 = *(const f32x4*)(op + 4);
        sum[0] += x0[0]; sum[1] += x0[1]; sum[2] += x0[2]; sum[3] += x0[3]; sum[4] += x1[0]; sum[5] += x1[1]; sum[6] += x1[2]; sum[7] += x1[3];
      }
      if (ret) {
        const float myqs = qsc[vrow];
#pragma unroll
        for (int e = 0; e < 8; ++e) sum[e] *= myqs;
      }
      if (second) {
        sum[0] += bflo(ocur.x); sum[1] += bfhi(ocur.x); sum[2] += bflo(ocur.y); sum[3] += bfhi(ocur.y);
        sum[4] += bflo(ocur.z); sum[5] += bfhi(ocur.z); sum[6] += bflo(ocur.w); sum[7] += bfhi(ocur.w);
      }
      u32x4 w; w.x = pk(sum[0], sum[1]); w.y = pk(sum[2], sum[3]); w.z = pk(sum[4], sum[5]); w.w = pk(sum[6], sum[7]);
      gst<u32x4>(og + ((size_t)n * 64 + vrow) * LDO + vch * 8, w);
      if (second) {
        float q2 = bflo(w.x) * bflo(w.x) + bfhi(w.x) * bfhi(w.x) + bflo(w.y) * bflo(w.y) + bfhi(w.y) * bfhi(w.y) +
                   bflo(w.z) * bflo(w.z) + bfhi(w.z) * bfhi(w.z) + bflo(w.w) * bflo(w.w) + bfhi(w.w) * bfhi(w.w);
        q2 += __shfl_xor(q2, 1); q2 += __shfl_xor(q2, 2); q2 += __shfl_xor(q2, 4);
        if (vch == 0) gst<float>(a.ssp + ((size_t)b * L_ + (size_t)n * 64 + vrow) * 32 + h * 8 + slice, q2);
      }
    }
  };
  if (active) {
    issue(RA, chunk_of(0)); issue1(chunk_of(0));
    if (DEPTH == 2) {
      issue(RB, chunk_of(1));
      for (int step = 0; step < 64; step += 2) { step_fn(RA, step, FalseC{}); step_fn(RB, step + 1, FalseC{}); }
    } else {
      for (int step = 0; step < 64; ++step) step_fn(RA, step, FalseC{});
    }
  }
  xcd_barrier(xb);
  if (active) {
    if (DEPTH == 2) {
      for (int step = 64; step < 128; step += 2) { step_fn(RA, step, TrueC{}); step_fn(RB, step + 1, TrueC{}); }
    } else {
      for (int step = 64; step < 128; ++step) step_fn(RA, step, TrueC{});
    }
  }
}

__global__ void __launch_bounds__(512, 2) mega(Params p) {
  cg::grid_group grid = cg::this_grid();
  extern __shared__ __attribute__((aligned(16))) char lds[];
  char* ws = KP(ws);
  volatile LAS unsigned* xst = (volatile LAS unsigned*)(LAS char*)(lds + (LDS_BYTES - 16));
  if (threadIdx.x == 0) { xst[0] = 0u; xst[1] = 0u; }
  __syncthreads();
  XcdBarrier xb = xcd_barrier_post((unsigned*)(ws + OFF_BAR), xst);
  rw_phase(KP(x), (bf16_t*)(ws + OFF_D), nullptr, nullptr, (float*)(ws + OFF_RS + 512 * 1024), nullptr);
  wconv_layer(0, (float*)lds);
  if (gridDim.x == 0x7fffffffu) grid.sync();
  xcd_barrier(xb);

  for (int layer = 0; layer < 4; ++layer) {
    const int kind0 = layer % 3;
    const int nsteps = (kind0 == 0 ? 6 : kind0 == 1 ? 4 : 7) + 3;
    const int nmix = nsteps - 3;
    for (int s = 0; s < nsteps; ++s) {
      int lyr = layer; asm volatile("" : "+s"(lyr));
      const int kind = (lyr == 3) ? 0 : lyr;
      char* ws = KP(ws);
      bf16_t* W = (bf16_t*)(ws + OFF_W);
      bf16_t* bA = (bf16_t*)(ws + OFF_A); bf16_t* bB = (bf16_t*)(ws + OFF_B); bf16_t* bC = (bf16_t*)(ws + OFF_C); bf16_t* bU = (bf16_t*)(ws + OFF_D);
      bf16_t* bP = (bf16_t*)(ws + OFF_P);
      float* rs = (float*)(ws + OFF_RS); float* Eb = (float*)(ws + OFF_E); float* t1 = (float*)(ws + OFF_T1);
      float* rh = (float*)(ws + OFF_RS + 512 * 1024);
      const float* G = KP(norm_gains);
      const float* gl = G + lyr * 4096;
      GemmDesc g{}; bool is_gemm = false;

      const int ms = s - nmix;
      if (ms == 0) { is_gemm = true; g.A = bU; g.Bt = W + W_UP; g.N = 4096; g.K = 1024; g.epi = EPI_RELU2; g.o0 = bA; g.rowscale = rh; }
      else if (ms == 1) { is_gemm = true; g.A = bA; g.Bt = W + W_DN; g.N = 1024; g.K = 4096; g.epi = EPI_PLAIN; g.o0 = bC; }
      else if (ms == 2) {
        rw_phase(nullptr, bU, bC, gl + 3072, rh, (lyr < 3) ? nullptr : KP(out));
        if (lyr < 3) wconv_layer(lyr + 1, (float*)lds);
      } else if (kind == 0) {
        const float* dec = KP(ret_decay) + (lyr / 3) * 8;
        if (s == 0) { is_gemm = true; g.A = bU; g.Bt = W + W_IN; g.N = 4096; g.K = 1024; g.epi = EPI_RETQKV; g.o0 = bA; g.o1 = bB; g.pos = KP(pos); g.rowscale = rh; }
        else if (s == 1) ppass_phase<256, false>(bA, bA + 1024, nullptr, nullptr, 2048, dec, bP);
        else if (s == 2) {
          ScanArgs a{}; a.q0 = a.q1 = bA; a.k0 = a.k1 = bA + 1024; a.v = bB; a.P = bP; a.o = bC;
          a.E = nullptr; a.decay = dec; a.ssp = t1;
          scan_phase<256>(a, lds, xb);
        }
        else if (s == 3) { is_gemm = true; g.A = bU; g.Bt = W + W_G; g.N = 2048; g.K = 1024; g.epi = EPI_GATE; g.dvshift = 9; g.o0 = bC; g.f0 = t1; g.c0 = nullptr; g.rowscale = rh; }
        else if (s == 4) { is_gemm = true; g.A = bC; g.Bt = W + W_OUT; g.N = 1024; g.K = 2048; g.epi = EPI_PLAIN; g.o0 = bA; }
        else rw_phase(nullptr, bU, bA, gl + 1024, rh, nullptr);
      } else if (kind == 1) {
        if (s == 0) { is_gemm = true; g.A = bU; g.Bt = W + W_IN; g.N = 2048; g.K = 1024; g.epi = EPI_GLU; g.o0 = bA; g.bias = KP(conv_b_in); g.rowscale = rh; }
        else if (s == 1) conv_phase(bA, bB, lds);
        else if (s == 2) { is_gemm = true; g.A = bB; g.Bt = W + W_OUT; g.N = 1024; g.K = 1024; g.epi = EPI_PLAIN; g.o0 = bC; g.bias = KP(conv_b_out); }
        else rw_phase(nullptr, bU, bC, gl + 1024, rh, nullptr);
      } else {
        bf16_t* gv = bA + (size_t)T_ * 1024; bf16_t* qkb = bB + (size_t)T_ * 1024; bf16_t* gy = bC + (size_t)T_ * 1024;
        if (s == 0) { is_gemm = true; g.A = bU; g.Bt = W + W_IN; g.N = 2304; g.K = 1024; g.epi = EPI_GLA; g.o0 = bA; g.o1 = gv; g.f0 = t1; g.rowscale = rh; }
        else if (s == 1) glaprep_phase(bA, t1, bB, qkb, Eb, lds);
        else if (s == 2) ppass_phase<128, true>(bB, bB + 512, qkb, qkb + 512, 1024, nullptr, bP);
        else if (s == 3) {
          ScanArgs a{}; a.q0 = bB; a.k0 = bB + 512; a.q1 = qkb; a.k1 = qkb + 512; a.v = gv; a.P = bP; a.o = bC;
          a.E = Eb; a.decay = nullptr; a.ssp = t1;
          scan_phase<128>(a, lds, xb);
        }
        else if (s == 4) { is_gemm = true; g.A = bU; g.Bt = W + W_G; g.N = 1024; g.K = 1024; g.epi = EPI_GATE; g.dvshift = 8; g.o0 = bC; g.f0 = t1; g.c0 = KP(gla_ng); g.rowscale = rh; }
        else if (s == 5) { is_gemm = true; g.A = bC; g.Bt = W + W_OUT; g.N = 1024; g.K = 1024; g.epi = EPI_PLAIN; g.o0 = gy; }
        else rw_phase(nullptr, bU, gy, gl + 1024, rh, nullptr);
      }
      if (is_gemm) gemm_phase(g, (LAS unsigned char*)lds);
      xcd_barrier(xb);
    }
  }
}

extern "C" void kernel_launch(void* const* d_in, const int* in_sizes, int n_in, void* d_out, int out_size,
                              void* d_ws, size_t ws_size, hipStream_t stream) {
  static int grid_blocks = 0;
  if (!grid_blocks) {
    (void)hipFuncSetAttribute((const void*)mega, hipFuncAttributeMaxDynamicSharedMemorySize, (int)LDS_BYTES);
    int dev = 0, cus = 0;
    (void)hipGetDevice(&dev);
    (void)hipDeviceGetAttribute(&cus, hipDeviceAttributeMultiprocessorCount, dev);
    grid_blocks = cus;
  }
  if (ws_size < 505 * MiB) { fprintf(stderr, "workspace too small: %zu\n", ws_size); return; }
  Params p{};
  p.x = (const float*)d_in[0]; p.pos = (const int*)d_in[1]; p.norm_gains = (const float*)d_in[2];
  p.ret_w_in = (const float*)d_in[3]; p.ret_decay = (const float*)d_in[4]; p.ret_w_out = (const float*)d_in[5];
  p.conv_w_in = (const float*)d_in[6]; p.conv_b_in = (const float*)d_in[7]; p.conv_w_dw = (const float*)d_in[8]; p.conv_b_dw = (const float*)d_in[9];
  p.conv_ln_g = (const float*)d_in[10]; p.conv_ln_b = (const float*)d_in[11]; p.conv_w_out = (const float*)d_in[12]; p.conv_b_out = (const float*)d_in[13];
  p.gla_w_in = (const float*)d_in[14]; p.gla_w1 = (const float*)d_in[15]; p.gla_w2 = (const float*)d_in[16]; p.gla_gb = (const float*)d_in[17];
  p.gla_ng = (const float*)d_in[18]; p.gla_w_out = (const float*)d_in[19]; p.mlp_up = (const float*)d_in[20]; p.mlp_down = (const float*)d_in[21];
  p.out = (float*)d_out; p.ws = (char*)d_ws;
  (void)hipMemsetAsync((char*)d_ws + OFF_BAR, 0, XCD_BAR_WORDS * 4, stream);
  void* args[] = {&p};
  hipError_t e = hipLaunchCooperativeKernel((void*)mega, dim3(grid_blocks), dim3(512), args, LDS_BYTES, stream);
  if (e != hipSuccess) fprintf(stderr, "cooperative launch failed: %s (grid %d)\n", hipGetErrorString(e), grid_blocks);
}
```

```cpp
#include <hip/hip_runtime.h>
#include <hip/hip_cooperative_groups.h>
#include <cstdio>
#include <cstdint>
namespace cg = cooperative_groups;

#define DI __device__ __forceinline__
typedef unsigned short bf16_t;
typedef short bf16x8 __attribute__((ext_vector_type(8)));
typedef short s16x4 __attribute__((ext_vector_type(4)));
typedef float f32x2 __attribute__((ext_vector_type(2)));
typedef float f32x4 __attribute__((ext_vector_type(4)));
typedef float f32x16 __attribute__((ext_vector_type(16)));
typedef unsigned u32x2 __attribute__((ext_vector_type(2)));
typedef unsigned u32x4 __attribute__((ext_vector_type(4)));
typedef __bf16 bf2_t __attribute__((ext_vector_type(2)));

constexpr int T_ = 32768, L_ = 8192;
constexpr float EPS = 1e-6f;
constexpr size_t MiB = 1u << 20;
constexpr size_t OFF_W = 0, OFF_A = 32 * MiB, OFF_B = 160 * MiB, OFF_C = 288 * MiB, OFF_D = 416 * MiB, OFF_P = 480 * MiB,
                 OFF_RS = 496 * MiB, OFF_E = 497 * MiB, OFF_T1 = 500 * MiB, OFF_BAR = 504 * MiB;
constexpr size_t LDS_BYTES = 163840;

struct Params {
  const float* x; const int* pos; const float* norm_gains;
  const float* ret_w_in; const float* ret_decay; const float* ret_w_out;
  const float* conv_w_in; const float* conv_b_in; const float* conv_w_dw; const float* conv_b_dw; const float* conv_ln_g; const float* conv_ln_b;
  const float* conv_w_out; const float* conv_b_out;
  const float* gla_w_in; const float* gla_w1; const float* gla_w2; const float* gla_gb; const float* gla_ng; const float* gla_w_out;
  const float* mlp_up; const float* mlp_down;
  float* out; char* ws;
};

DI unsigned pk(float lo, float hi) { f32x2 v = {lo, hi}; bf2_t b = __builtin_convertvector(v, bf2_t); return __builtin_bit_cast(unsigned, b); }
DI float bflo(unsigned w) { return __uint_as_float(w << 16); }
DI float bfhi(unsigned w) { return __uint_as_float(w & 0xffff0000u); }
DI float bf1(bf16_t h) { return __uint_as_float(((unsigned)h) << 16); }
DI bf16_t tobf(float f) { return (bf16_t)(pk(f, 0.f) & 0xffffu); }
DI float sigmoidf_(float x) { return 1.0f / (1.0f + __expf(-x)); }
DI const void* karg(int off) {
  const char* kp = (const char*)__builtin_amdgcn_kernarg_segment_ptr();
  const void* r;
  asm volatile("s_load_dwordx2 %0, %1, %2\n\ts_waitcnt lgkmcnt(0)" : "=s"(r) : "s"(kp), "s"(off) : "memory");
  return r;
}
typedef __attribute__((address_space(1))) char gchar_t;
#define KP(f) ((decltype(Params::f))(char*)(gchar_t*)(char*)karg((int)offsetof(Params, f)))
#define GAS __attribute__((address_space(1)))
template <class T> DI T gld(const void* p) { return *(const GAS T*)(const GAS char*)(const char*)p; }
template <class T> DI void gst(void* p, T v) { *(GAS T*)(GAS char*)(char*)p = v; }
DI float log_sigmoid_(float x) {
  const float e = __expf(-fabsf(x));
  const float l1p = (e < 0.0625f) ? e * (1.0f + e * (-0.5f + e * (0.33333334f + e * (-0.25f + e * (0.2f + e * (-0.16666667f + e * 0.14285715f)))))) : __logf(1.0f + e);
  return fminf(x, 0.f) - l1p;
}
DI void lds_barrier() { asm volatile("s_waitcnt lgkmcnt(0)" ::: "memory"); __builtin_amdgcn_s_barrier(); asm volatile("" ::: "memory"); }
DI int obid() { int b = blockIdx.x; asm volatile("" : "+s"(b)); return b; }
DI int otid() { int t = threadIdx.x; asm volatile("" : "+v"(t)); return t; }
DI float wave_sum(float v) {
#pragma unroll
  for (int o = 1; o < 64; o <<= 1) v += __shfl_xor(v, o);
  return v;
}


#define XB_TMO      128
#define XB_XCNT(j)  (256  + 64 * (j))
#define XB_XSUB(j)  (1280 + 64 * (j))
#define XB_XGEN(j)  (2304 + 64 * (j))
#define XB_TOP      3328
#define XB_TOPGEN   3392
#define XCD_BAR_WORDS 3456
#define XB_SPIN_CAP (1u << 18)
#define LAS __attribute__((address_space(3)))
DI unsigned xb_ld(unsigned* p)              { return __hip_atomic_load(p, __ATOMIC_RELAXED, __HIP_MEMORY_SCOPE_AGENT); }
DI unsigned xb_add(unsigned* p, unsigned v) { return __hip_atomic_fetch_add(p, v, __ATOMIC_RELAXED, __HIP_MEMORY_SCOPE_AGENT); }
DI unsigned xb_xcc_id() { return (unsigned)__builtin_amdgcn_s_getreg((3 << 11) | 20) & 0xFu; }
#define XB_SPIN(cond, bar) do { unsigned _sp = 0; while (cond) { __builtin_amdgcn_s_sleep(1); \
    if ((++_sp & 255u) == 0u) { if (xb_ld(&(bar)[XB_TMO])) break; if (_sp > XB_SPIN_CAP) { atomicAdd(&(bar)[XB_TMO], 1u); break; } } } } while (0)
struct XcdBarrier { unsigned* bar; unsigned x; volatile LAS unsigned* st; };
DI XcdBarrier xcd_barrier_post(unsigned* bar, volatile LAS unsigned* st) {
  XcdBarrier b; b.bar = bar; b.x = xb_xcc_id(); b.st = st;
  if (threadIdx.x == 0) (void)xb_add(&bar[XB_XCNT(b.x)], 1u);
  return b;
}
DI void xcd_barrier_complete(unsigned* bar, unsigned x, unsigned& nloc, unsigned& nx) {
  const unsigned G = gridDim.x * gridDim.y * gridDim.z;
  unsigned sum, cnt, mine, sp = 0u;
  for (;;) {
    sum = 0u; cnt = 0u; mine = 0u;
#pragma unroll
    for (unsigned j = 0; j < 16; ++j) { const unsigned c = xb_ld(&bar[XB_XCNT(j)]); sum += c; cnt += (c > 0u) ? 1u : 0u; mine = (j == x) ? c : mine; }
    if (sum == G) break;
    __builtin_amdgcn_s_sleep(1);
    if ((++sp & 255u) == 0u) { if (xb_ld(&bar[XB_TMO])) break; if (sp > XB_SPIN_CAP) { atomicAdd(&bar[XB_TMO], 1u); break; } }
  }
  nloc = mine > 0u ? mine : 1u; nx = cnt > 0u ? cnt : 1u;
}
DI void xcd_barrier(const XcdBarrier& b) {
  asm volatile("s_waitcnt vmcnt(0)" ::: "memory");
  __syncthreads();
  if (threadIdx.x == 0) {
    unsigned* bar = b.bar;
    __builtin_amdgcn_s_waitcnt(0);
    unsigned nloc = b.st[0], nx = b.st[1];
    if (nloc == 0u) { xcd_barrier_complete(bar, b.x, nloc, nx); b.st[0] = nloc; b.st[1] = nx; }
    const unsigned old = xb_add(&bar[XB_XSUB(b.x)], 1u);
    const unsigned gen = old / nloc;
    if (old + 1u == (gen + 1u) * nloc) {
      __builtin_amdgcn_fence(__ATOMIC_RELEASE, "agent");
      asm volatile("s_waitcnt vmcnt(0)" ::: "memory");
      const unsigned og = xb_add(&bar[XB_TOP], 1u);
      const unsigned tg = og / nx;
      if (og + 1u == (tg + 1u) * nx) xb_add(&bar[XB_TOPGEN], 1u);
      else XB_SPIN(xb_ld(&bar[XB_TOPGEN]) == tg, bar);
      __builtin_amdgcn_fence(__ATOMIC_ACQUIRE, "agent");
      xb_add(&bar[XB_XGEN(b.x)], 1u);
      asm volatile("s_waitcnt vmcnt(0)" ::: "memory");
    } else {
      XB_SPIN(xb_ld(&bar[XB_XGEN(b.x)]) == gen, bar);
      __builtin_amdgcn_fence(__ATOMIC_ACQUIRE, "agent");
      asm volatile("s_waitcnt vmcnt(0)" ::: "memory");
    }
  }
  __syncthreads();
}

DI float wsrc(const float* src, int ld, int mode, const float* aux, int k, int n) {
  if (mode == 0) return gld<float>(src + (size_t)k * ld + n);
  if (mode == 1) { int c = ((n >> 7) & 1) * 1024 + (n >> 8) * 128 + (n & 127); return gld<float>(src + (size_t)k * ld + c); }
  if (n < 2048) return gld<float>(src + (size_t)k * ld + n);
  if (n < 2080) { int j = n - 2048; return gld<float>(aux + ((size_t)(j >> 4) * 1024 + k) * 16 + (j & 15)); }
  return 0.f;
}
DI void wconv_job(const float* src, int ld, int K, int Nd, bf16_t* dst, int mode, const float* aux, float* tile, const float* gain) {
  const int tk = K >> 6, tn = Nd >> 6, nt = tk * tn, tid = otid();
  for (int t = blockIdx.x; t < nt; t += gridDim.x) {
    const int k0 = (t % tk) << 6, n0 = (t / tk) << 6;
    __syncthreads();
    if (mode == 0) {
#pragma unroll
      for (int i = 0; i < 2; ++i) {
        const int kk = (tid >> 4) + 32 * i, n4 = (tid & 15) * 4;
        f32x4 v = gld<f32x4>(src + (size_t)(k0 + kk) * ld + n0 + n4);
        if (gain) v = v * gld<float>(gain + k0 + kk);
        tile[kk * 65 + n4] = v[0]; tile[kk * 65 + n4 + 1] = v[1]; tile[kk * 65 + n4 + 2] = v[2]; tile[kk * 65 + n4 + 3] = v[3];
      }
    } else {
#pragma unroll
      for (int i = 0; i < 8; ++i) { int kk = (tid >> 6) + 8 * i, nn = tid & 63; tile[kk * 65 + nn] = wsrc(src, ld, mode, aux, k0 + kk, n0 + nn) * (gain ? gld<float>(gain + k0 + kk) : 1.0f); }
    }
    __syncthreads();
    const int nn = tid >> 3, k8 = (tid & 7) * 8;
    u32x4 w;
    w.x = pk(tile[(k8 + 0) * 65 + nn], tile[(k8 + 1) * 65 + nn]); w.y = pk(tile[(k8 + 2) * 65 + nn], tile[(k8 + 3) * 65 + nn]);
    w.z = pk(tile[(k8 + 4) * 65 + nn], tile[(k8 + 5) * 65 + nn]); w.w = pk(tile[(k8 + 6) * 65 + nn], tile[(k8 + 7) * 65 + nn]);
    gst<u32x4>(dst + (size_t)(n0 + nn) * K + k0 + k8, w);
  }
}
constexpr size_t W_IN = 0;
constexpr size_t W_G = 4096u * 1024u;
constexpr size_t W_OUT = 6144u * 1024u;
constexpr size_t W_UP = 8192u * 1024u;
constexpr size_t W_DN = 12288u * 1024u;
DI void wconv_layer(int layer, float* tile) {
  bf16_t* W = (bf16_t*)(KP(ws) + OFF_W);
  const int kind = layer % 3, j = layer / 3;
  const float* g0 = KP(norm_gains) + layer * 4096;
  const float* g2 = g0 + 2048;
  if (kind == 0) {
    const float* win = KP(ret_w_in) + (size_t)j * 1024 * 6144;
    wconv_job(win, 6144, 1024, 4096, W + W_IN, 0, nullptr, tile, g0);
    wconv_job(win + 4096, 6144, 1024, 2048, W + W_G, 0, nullptr, tile, g0);
    wconv_job(KP(ret_w_out) + (size_t)j * 2048 * 1024, 1024, 2048, 1024, W + W_OUT, 0, nullptr, tile, nullptr);
  } else if (kind == 1) {
    wconv_job(KP(conv_w_in), 2048, 1024, 2048, W + W_IN, 1, nullptr, tile, g0);
    wconv_job(KP(conv_w_out), 1024, 1024, 1024, W + W_OUT, 0, nullptr, tile, nullptr);
  } else {
    wconv_job(KP(gla_w_in), 3072, 1024, 2304, W + W_IN, 2, KP(gla_w1), tile, g0);
    wconv_job(KP(gla_w_in) + 2048, 3072, 1024, 1024, W + W_G, 0, nullptr, tile, g0);
    wconv_job(KP(gla_w_out), 1024, 1024, 1024, W + W_OUT, 0, nullptr, tile, nullptr);
  }
  wconv_job(KP(mlp_up) + (size_t)layer * 1024 * 4096, 4096, 1024, 4096, W + W_UP, 0, nullptr, tile, g2);
  wconv_job(KP(mlp_down) + (size_t)layer * 4096 * 1024, 1024, 4096, 1024, W + W_DN, 0, nullptr, tile, nullptr);
}

DI void rw_phase(const float* x, bf16_t* hb, const bf16_t* y, const float* gpost, float* rh, float* fout, bool y_unscaled) {
  const int tid_ = otid(), wid = tid_ >> 6, lane = tid_ & 63;
  for (int row = blockIdx.x * 8 + wid; row < T_; row += gridDim.x * 8) {
    float hv[16];
    if (x) {
      const float* hp = x + (size_t)row * 1024;
#pragma unroll
      for (int c = 0; c < 2; ++c) {
        const f32x4 a = gld<f32x4>(hp + 512 * c + 8 * lane), b = gld<f32x4>(hp + 512 * c + 8 * lane + 4);
        hv[8 * c + 0] = a[0]; hv[8 * c + 1] = a[1]; hv[8 * c + 2] = a[2]; hv[8 * c + 3] = a[3];
        hv[8 * c + 4] = b[0]; hv[8 * c + 5] = b[1]; hv[8 * c + 6] = b[2]; hv[8 * c + 7] = b[3];
      }
    } else {
#pragma unroll
      for (int c = 0; c < 2; ++c) {
        const u32x4 w = gld<u32x4>(hb + (size_t)row * 1024 + 512 * c + 8 * lane);
        hv[8 * c + 0] = bflo(w.x); hv[8 * c + 1] = bfhi(w.x); hv[8 * c + 2] = bflo(w.y); hv[8 * c + 3] = bfhi(w.y);
        hv[8 * c + 4] = bflo(w.z); hv[8 * c + 5] = bfhi(w.z); hv[8 * c + 6] = bflo(w.w); hv[8 * c + 7] = bfhi(w.w);
      }
    }
    if (y) {
      float yv[16]; float ss = 0.f;
#pragma unroll
      for (int c = 0; c < 2; ++c) {
        const u32x4 w = gld<u32x4>(y + (size_t)row * 1024 + 512 * c + 8 * lane);
        yv[8 * c + 0] = bflo(w.x); yv[8 * c + 1] = bfhi(w.x); yv[8 * c + 2] = bflo(w.y); yv[8 * c + 3] = bfhi(w.y);
        yv[8 * c + 4] = bflo(w.z); yv[8 * c + 5] = bfhi(w.z); yv[8 * c + 6] = bflo(w.w); yv[8 * c + 7] = bfhi(w.w);
      }
#pragma unroll
      for (int i = 0; i < 16; ++i) ss += yv[i] * yv[i];
      ss = wave_sum(ss);
      float epsn = EPS;
      if (y_unscaled) { const float r = gld<float>(rh + row), r2 = r * r; epsn = EPS / (r2 * r2); }
      const float ry = rsqrtf(ss * (1.0f / 1024.0f) + epsn);
#pragma unroll
      for (int c = 0; c < 2; ++c) {
        const f32x4 g0 = gld<f32x4>(gpost + 512 * c + 8 * lane), g1 = gld<f32x4>(gpost + 512 * c + 8 * lane + 4);
#pragma unroll
        for (int i = 0; i < 4; ++i) { hv[8 * c + i] += yv[8 * c + i] * ry * g0[i]; hv[8 * c + 4 + i] += yv[8 * c + 4 + i] * ry * g1[i]; }
      }
    }
    if (fout) {
      float* op = fout + (size_t)row * 1024;
#pragma unroll
      for (int c = 0; c < 2; ++c) {
        gst<f32x4>(op + 512 * c + 8 * lane, (f32x4){hv[8 * c], hv[8 * c + 1], hv[8 * c + 2], hv[8 * c + 3]});
        gst<f32x4>(op + 512 * c + 8 * lane + 4, (f32x4){hv[8 * c + 4], hv[8 * c + 5], hv[8 * c + 6], hv[8 * c + 7]});
      }
    } else {
      float s2 = 0.f;
#pragma unroll
      for (int c = 0; c < 2; ++c) {
        u32x4 w;
        w.x = pk(hv[8 * c + 0], hv[8 * c + 1]); w.y = pk(hv[8 * c + 2], hv[8 * c + 3]); w.z = pk(hv[8 * c + 4], hv[8 * c + 5]); w.w = pk(hv[8 * c + 6], hv[8 * c + 7]);
        gst<u32x4>(hb + (size_t)row * 1024 + 512 * c + 8 * lane, w);
        s2 += bflo(w.x) * bflo(w.x) + bfhi(w.x) * bfhi(w.x) + bflo(w.y) * bflo(w.y) + bfhi(w.y) * bfhi(w.y) +
              bflo(w.z) * bflo(w.z) + bfhi(w.z) * bfhi(w.z) + bflo(w.w) * bflo(w.w) + bfhi(w.w) * bfhi(w.w);
      }
      s2 = wave_sum(s2);
      if (lane == 0) gst<float>(rh + row, rsqrtf(s2 * (1.0f / 1024.0f) + EPS));
    }
  }
}

DI void stats_phase(const bf16_t* o, int HW, float* rs) {
  const int tid_ = otid(), wid = tid_ >> 6, lane = tid_ & 63;
  for (int row = blockIdx.x * 8 + wid; row < T_; row += gridDim.x * 8) {
    if (HW == 2048) {
#pragma unroll
      for (int c = 0; c < 4; ++c) {
        u32x4 w = gld<u32x4>(o + (size_t)row * 2048 + 512 * c + 8 * lane);
        float s = bflo(w.x) * bflo(w.x) + bfhi(w.x) * bfhi(w.x) + bflo(w.y) * bflo(w.y) + bfhi(w.y) * bfhi(w.y) +
                  bflo(w.z) * bflo(w.z) + bfhi(w.z) * bfhi(w.z) + bflo(w.w) * bflo(w.w) + bfhi(w.w) * bfhi(w.w);
        s = wave_sum(s);
        if (lane == 0) gst<float>(rs + row * 4 + c, rsqrtf(s * (1.0f / 512.0f) + EPS));
      }
    } else {
#pragma unroll
      for (int c = 0; c < 2; ++c) {
        u32x4 w = gld<u32x4>(o + (size_t)row * 1024 + 512 * c + 8 * lane);
        float s = bflo(w.x) * bflo(w.x) + bfhi(w.x) * bfhi(w.x) + bflo(w.y) * bflo(w.y) + bfhi(w.y) * bfhi(w.y) +
                  bflo(w.z) * bflo(w.z) + bfhi(w.z) * bfhi(w.z) + bflo(w.w) * bflo(w.w) + bfhi(w.w) * bfhi(w.w);
#pragma unroll
        for (int of = 1; of < 32; of <<= 1) s += __shfl_xor(s, of);
        if ((lane & 31) == 0) gst<float>(rs + row * 4 + 2 * c + (lane >> 5), rsqrtf(s * (1.0f / 256.0f) + EPS));
      }
    }
  }
}

constexpr int BM = 256, BK = 64, HALF = 128, NXCD = 8, WGM = 8, HT = HALF * BK;
enum { EPI_PLAIN = 0, EPI_RELU2 = 1, EPI_RETQKV = 2, EPI_GATE = 3, EPI_GLU = 4, EPI_GLA = 5 };
struct GemmDesc {
  const bf16_t* A; const bf16_t* Bt; int N; int K; int epi; int dvshift;
  bf16_t* o0; bf16_t* o1; float* f0; const float* bias; const float* c0; const int* pos; const float* rowscale;
};
DI int lds_byte(int r, int c) { int st = (r >> 4) * 2 + (c >> 5), rr = r & 15, cc = c & 31, ob = rr * 64 + cc * 2; return st * 1024 + (ob ^ (((ob >> 9) & 1) << 5)); }
DI void stage_rc(int b, int& R, int& C) { int st = b / 1024, sb = b % 1024, swz = sb ^ (((sb >> 9) & 1) << 5); R = (st >> 1) * 16 + swz / 64; C = (st & 1) * 32 + (swz % 64) / 2; }

DI void gemm_epilogue(const GemmDesc& g, f32x4 (&acc)[2][2][4][2], int brow, int bcol, int wr, int wc, int fr, int fq) {
  const int epi = g.epi;
  const int rowb = brow + wr * 64 + fr, colb = bcol + wc * 32 + 8 * fq;
  if (epi == EPI_PLAIN || epi == EPI_RELU2) {
    const int N = g.N;
#pragma unroll
    for (int bj = 0; bj < 2; ++bj) {
      const int col = colb + bj * HALF;
      f32x4 b0 = {0.f, 0.f, 0.f, 0.f}, b1 = b0;
      if (g.bias) { b0 = gld<f32x4>(g.bias + col); b1 = gld<f32x4>(g.bias + col + 4); }
#pragma unroll
      for (int ai = 0; ai < 2; ++ai)
#pragma unroll
        for (int m = 0; m < 4; ++m) {
          const int row = rowb + ai * HALF + m * 16;
          f32x4 v0 = acc[ai][bj][m][0], v1 = acc[ai][bj][m][1];
          if (g.rowscale) { const float ru = gld<float>(g.rowscale + row); v0 = v0 * ru; v1 = v1 * ru; }
          v0 = v0 + b0; v1 = v1 + b1;
          if (epi == EPI_RELU2) {
#pragma unroll
            for (int j = 0; j < 4; ++j) { float r0 = fmaxf(v0[j], 0.f), r1 = fmaxf(v1[j], 0.f); v0[j] = r0 * r0; v1[j] = r1 * r1; }
          }
          u32x4 w; w.x = pk(v0[0], v0[1]); w.y = pk(v0[2], v0[3]); w.z = pk(v1[0], v1[1]); w.w = pk(v1[2], v1[3]);
          gst<u32x4>(g.o0 + (size_t)row * N + col, w);
        }
    }
  } else if (epi == EPI_RETQKV) {
    if (bcol < 2048) {
      const float sc = (bcol < 1024) ? 0.0625f : 1.0f;
      const int d0 = wc * 32 + 8 * fq;
      float fr_[8];
#pragma unroll
      for (int j = 0; j < 8; ++j) fr_[j] = exp2f(-(float)(d0 + j) * (13.287712379549449f / 128.0f)) * 0.15915494309189535f;
#pragma unroll
      for (int ai = 0; ai < 2; ++ai)
#pragma unroll
        for (int m = 0; m < 4; ++m) {
          const int row = rowb + ai * HALF + m * 16;
          const float pf = (float)gld<int>(g.pos + row);
          const float scr = sc * gld<float>(g.rowscale + row);
          float y1[8], y2[8];
#pragma unroll
          for (int n = 0; n < 2; ++n) {
            const f32x4 x1 = acc[ai][0][m][n], x2 = acc[ai][1][m][n];
#pragma unroll
            for (int j = 0; j < 4; ++j) {
              float rev = pf * fr_[4 * n + j]; rev = rev - rintf(rev);
              const float sn = __builtin_amdgcn_sinf(rev), cs = __builtin_amdgcn_cosf(rev);
              y1[4 * n + j] = (x1[j] * cs - x2[j] * sn) * scr; y2[4 * n + j] = (x2[j] * cs + x1[j] * sn) * scr;
            }
          }
          u32x4 w1, w2;
          w1.x = pk(y1[0], y1[1]); w1.y = pk(y1[2], y1[3]); w1.z = pk(y1[4], y1[5]); w1.w = pk(y1[6], y1[7]);
          w2.x = pk(y2[0], y2[1]); w2.y = pk(y2[2], y2[3]); w2.z = pk(y2[4], y2[5]); w2.w = pk(y2[6], y2[7]);
          bf16_t* op = g.o0 + (size_t)row * 2048 + bcol + d0;
          gst<u32x4>(op, w1); gst<u32x4>(op + 128, w2);
        }
    } else {
#pragma unroll
      for (int bj = 0; bj < 2; ++bj) {
        const int col = colb - 2048 + bj * HALF;
#pragma unroll
        for (int ai = 0; ai < 2; ++ai)
#pragma unroll
          for (int m = 0; m < 4; ++m) {
            const int row = rowb + ai * HALF + m * 16;
            const float ru = gld<float>(g.rowscale + row);
            const f32x4 v0 = acc[ai][bj][m][0] * ru, v1 = acc[ai][bj][m][1] * ru;
            u32x4 w; w.x = pk(v0[0], v0[1]); w.y = pk(v0[2], v0[3]); w.z = pk(v1[0], v1[1]); w.w = pk(v1[2], v1[3]);
            gst<u32x4>(g.o1 + (size_t)row * 2048 + col, w);
          }
      }
    }
  } else if (epi == EPI_GATE) {
    const int N = g.N, dvm = (1 << g.dvshift) - 1;
#pragma unroll
    for (int bj = 0; bj < 2; ++bj) {
      const int col = colb + bj * HALF;
      f32x4 g0 = {1.f, 1.f, 1.f, 1.f}, g1 = g0;
      if (g.c0) { g0 = gld<f32x4>(g.c0 + (col & dvm)); g1 = gld<f32x4>(g.c0 + (col & dvm) + 4); }
      const int head = col >> g.dvshift;
#pragma unroll
      for (int ai = 0; ai < 2; ++ai)
#pragma unroll
        for (int m = 0; m < 4; ++m) {
          const int row = rowb + ai * HALF + m * 16;
          float rs;
          { const float* sp = g.f0 + (size_t)row * 32 + head * 8;
            const f32x4 s0 = gld<f32x4>(sp); float ssum = (s0[0] + s0[1]) + (s0[2] + s0[3]);
            if (g.dvshift == 9) { const f32x4 s1 = gld<f32x4>(sp + 4); ssum += (s1[0] + s1[1]) + (s1[2] + s1[3]); }
            rs = rsqrtf(ssum * (g.dvshift == 9 ? (1.0f / 512.0f) : (1.0f / 256.0f)) + EPS); }
          bf16_t* op = g.o0 + (size_t)row * N + col;
          const u32x4 ow = gld<u32x4>(op);
          const float ru = gld<float>(g.rowscale + row);
          const f32x4 v0 = acc[ai][bj][m][0] * ru, v1 = acc[ai][bj][m][1] * ru;
          float o[8] = {bflo(ow.x), bfhi(ow.x), bflo(ow.y), bfhi(ow.y), bflo(ow.z), bfhi(ow.z), bflo(ow.w), bfhi(ow.w)};
#pragma unroll
          for (int j = 0; j < 4; ++j) { o[j] = o[j] * rs * g0[j] * v0[j] * sigmoidf_(v0[j]); o[4 + j] = o[4 + j] * rs * g1[j] * v1[j] * sigmoidf_(v1[j]); }
          u32x4 w; w.x = pk(o[0], o[1]); w.y = pk(o[2], o[3]); w.z = pk(o[4], o[5]); w.w = pk(o[6], o[7]);
          gst<u32x4>(op, w);
        }
    }
  } else if (epi == EPI_GLU) {
    const int ca = 128 * (bcol >> 8) + wc * 32 + 8 * fq;
    const f32x4 ba0 = gld<f32x4>(g.bias + ca), ba1 = gld<f32x4>(g.bias + ca + 4);
    const f32x4 bg0 = gld<f32x4>(g.bias + 1024 + ca), bg1 = gld<f32x4>(g.bias + 1024 + ca + 4);
#pragma unroll
    for (int ai = 0; ai < 2; ++ai)
#pragma unroll
      for (int m = 0; m < 4; ++m) {
        const int row = rowb + ai * HALF + m * 16;
        const float ru = gld<float>(g.rowscale + row);
        const f32x4 a0 = acc[ai][0][m][0] * ru + ba0, a1 = acc[ai][0][m][1] * ru + ba1, t0 = acc[ai][1][m][0] * ru + bg0, t1 = acc[ai][1][m][1] * ru + bg1;
        float o[8];
#pragma unroll
        for (int j = 0; j < 4; ++j) { o[j] = a0[j] * sigmoidf_(t0[j]); o[4 + j] = a1[j] * sigmoidf_(t1[j]); }
        u32x4 w; w.x = pk(o[0], o[1]); w.y = pk(o[2], o[3]); w.z = pk(o[4], o[5]); w.w = pk(o[6], o[7]);
        gst<u32x4>(g.o0 + (size_t)row * 1024 + ca, w);
      }
  } else {
#pragma unroll
    for (int bj = 0; bj < 2; ++bj) {
      const int col = colb + bj * HALF;
#pragma unroll
      for (int ai = 0; ai < 2; ++ai)
#pragma unroll
        for (int m = 0; m < 4; ++m) {
          const int row = rowb + ai * HALF + m * 16;
          const float ru = gld<float>(g.rowscale + row);
          f32x4 v0 = acc[ai][bj][m][0] * ru, v1 = acc[ai][bj][m][1] * ru;
          if (bcol < 2048) {
            if (bcol < 512) { v0 = v0 * 0.08838834764831845f; v1 = v1 * 0.08838834764831845f; }
            bf16_t* base = (bcol < 1024) ? (g.o0 + (size_t)row * 1024 + col) : (g.o1 + (size_t)row * 1024 + (col - 1024));
            u32x4 w; w.x = pk(v0[0], v0[1]); w.y = pk(v0[2], v0[3]); w.z = pk(v1[0], v1[1]); w.w = pk(v1[2], v1[3]);
            gst<u32x4>(base, w);
          } else if (col < 2080) {
            gst<f32x4>(g.f0 + (size_t)row * 32 + (col - 2048), v0); gst<f32x4>(g.f0 + (size_t)row * 32 + (col - 2048) + 4, v1);
          }
        }
    }
  }
}

DI int perm32(int rho) { const int n = rho >> 4, i = rho & 15; return 8 * (i >> 2) + 4 * n + (i & 3); }
DI bool tile_next(int i, int G, int c, int nM, int nN, int& pm, int& pn) {
  const int nwg = nM * nN; const long L = (long)i * G + c; if (L >= nwg) return false;
  int wgid = (int)L; { const int q = nwg / NXCD, r = nwg % NXCD, xcd = wgid % NXCD, off = wgid / NXCD; wgid = (xcd < r ? xcd * (q + 1) : r * (q + 1) + (xcd - r) * q) + off; }
  const int nig = WGM * nN, gid = wgid / nig, fm = gid * WGM, gsz = (nM - fm) < WGM ? (nM - fm) : WGM;
  pm = fm + ((wgid % nig) % gsz); pn = (wgid % nig) / gsz; return true;
}
DI void gemm_phase(const GemmDesc& g, LAS unsigned char* lds) {
  constexpr int HTB = HALF * BK * 2;
  const int tid = otid(), wid = __builtin_amdgcn_readfirstlane(tid >> 6), lane = tid & 63, wr = wid >> 2, wc = wid & 3, fr = lane & 15, fq = lane >> 4;
  const int K = g.K, nt = K / BK, nM = T_ / BM, nN = g.N / BM, G = gridDim.x, cb = blockIdx.x;
  unsigned voffA[2], voffB[2];
#pragma unroll
  for (int i = 0; i < 2; ++i) { int R, C; stage_rc(tid * 16 + i * 8192, R, C); const int Rb = (R & ~31) + perm32(R & 31);
    voffA[i] = (unsigned)(R * K + C) * 2u; voffB[i] = (unsigned)(Rb * K + C) * 2u; }
  const size_t kstep = (size_t)(BK * 2), hstep = (size_t)HALF * K * 2, tstep = 2 * hstep;
  const unsigned ldsw = (unsigned)wid * 1024u;
  const int aoff = lds_byte(wr * 64 + fr, fq * 8), boff = lds_byte(wc * 32 + fr, fq * 8);
#define PG8_SA(b, h) (((b) * 2 + (h)) * HTB)
#define PG8_SB(b, h) ((4 + (b) * 2 + (h)) * HTB)
#define PG8_STAGE(bufoff, gbase, voff) do { _Pragma("unroll") for (int _i = 0; _i < 2; ++_i) \
    __builtin_amdgcn_global_load_lds((const unsigned*)((const char*)(gbase) + (voff)[_i]), (LAS unsigned*)(lds + (bufoff) + ldsw + _i * 8192), 16, 0, 0); } while (0)
#define PG8_LDA(dst, b, h) do { _Pragma("unroll") for (int m = 0; m < 4; ++m) _Pragma("unroll") for (int k = 0; k < 2; ++k) dst[m][k] = *(const LAS bf16x8*)(lds + PG8_SA(b, h) + aoff + m * 2048 + k * 1024); } while (0)
#define PG8_LDB(dst, b, h) do { _Pragma("unroll") for (int n = 0; n < 2; ++n) _Pragma("unroll") for (int k = 0; k < 2; ++k) dst[n][k] = *(const LAS bf16x8*)(lds + PG8_SB(b, h) + boff + n * 2048 + k * 1024); } while (0)
#define PG8_MMA(ai, bj, At, Bt) do { __builtin_amdgcn_s_setprio(1); _Pragma("unroll") for (int m = 0; m < 4; ++m) _Pragma("unroll") for (int n = 0; n < 2; ++n) _Pragma("unroll") for (int k = 0; k < 2; ++k) \
    acc[ai][bj][m][n] = __builtin_amdgcn_mfma_f32_16x16x32_bf16(Bt[n][k], At[m][k], acc[ai][bj][m][n], 0, 0, 0); __builtin_amdgcn_s_setprio(0); } while (0)
#define PG8_WAIT_V(n) asm volatile("s_waitcnt vmcnt(" #n ")" ::: "memory")
#define PG8_WAIT_L(n) asm volatile("s_waitcnt lgkmcnt(" #n ")" ::: "memory")
#define PG8_BAR __builtin_amdgcn_s_barrier()
#define PG8_SCHED __builtin_amdgcn_sched_barrier(0)
  int cpm, cpn, npm = 0, npn = 0, ui = 0;
  if (!tile_next(0, G, cb, nM, nN, cpm, cpn)) return;
  f32x4 acc[2][2][4][2];
#pragma unroll
  for (int a = 0; a < 2; ++a)
#pragma unroll
    for (int b = 0; b < 2; ++b)
#pragma unroll
      for (int m = 0; m < 4; ++m)
#pragma unroll
        for (int n = 0; n < 2; ++n) acc[a][b][m][n] = (f32x4){0.f, 0.f, 0.f, 0.f};
  bf16x8 At[4][2], B0[2][2], B1[2][2];
  const char* cA = (const char*)g.A + (size_t)cpm * tstep; const char* cB = (const char*)g.Bt + (size_t)cpn * tstep;
  PG8_STAGE(PG8_SB(0, 0), cB, voffB); PG8_STAGE(PG8_SB(0, 1), cB + hstep, voffB); PG8_STAGE(PG8_SA(0, 0), cA, voffA); PG8_STAGE(PG8_SA(0, 1), cA + hstep, voffA);
  if (wr == 1) PG8_BAR;
  PG8_WAIT_V(2); PG8_BAR;
  PG8_STAGE(PG8_SB(1, 0), cB + kstep, voffB); PG8_STAGE(PG8_SA(1, 0), cA + kstep, voffA); PG8_STAGE(PG8_SB(1, 1), cB + hstep + kstep, voffB);
  PG8_WAIT_V(6); PG8_BAR;
  for (;;) {
    const bool has_next = tile_next(ui + 1, G, cb, nM, nN, npm, npn);
    const char* nA = has_next ? (const char*)g.A + (size_t)npm * tstep : cA; const char* nB = has_next ? (const char*)g.Bt + (size_t)npn * tstep : cB;
    for (int t = 0; t < nt; t += 2) {
      const bool last = (t == nt - 2);
      const char* a1 = cA + (size_t)(t + 1) * kstep;
      const char* a2 = last ? nA : cA + (size_t)(t + 2) * kstep; const char* b2 = last ? nB : cB + (size_t)(t + 2) * kstep;
      const char* a3 = a2 + kstep; const char* b3 = b2 + kstep;
      PG8_LDB(B0, 0, 0); PG8_LDB(B1, 0, 1); PG8_SCHED; PG8_LDA(At, 0, 0); PG8_STAGE(PG8_SA(1, 1), a1 + hstep, voffA);
      PG8_WAIT_V(8); PG8_WAIT_L(0); PG8_BAR; PG8_MMA(0, 0, At, B0); PG8_MMA(0, 1, At, B1); PG8_BAR; PG8_SCHED;
      PG8_LDA(At, 0, 1); PG8_STAGE(PG8_SB(0, 0), b2, voffB); PG8_STAGE(PG8_SB(0, 1), b2 + hstep, voffB); PG8_STAGE(PG8_SA(0, 0), a2, voffA);
      PG8_WAIT_V(8); PG8_WAIT_L(0); PG8_BAR; PG8_MMA(1, 0, At, B0); PG8_MMA(1, 1, At, B1); PG8_BAR; PG8_SCHED;
      PG8_LDB(B0, 1, 0); PG8_LDB(B1, 1, 1); PG8_SCHED; PG8_LDA(At, 1, 0); PG8_STAGE(PG8_SA(0, 1), a2 + hstep, voffA);
      PG8_WAIT_V(8); PG8_WAIT_L(0); PG8_BAR; PG8_MMA(0, 0, At, B0); PG8_MMA(0, 1, At, B1); PG8_BAR; PG8_SCHED;
      PG8_LDA(At, 1, 1); PG8_STAGE(PG8_SB(1, 0), b3, voffB); PG8_STAGE(PG8_SB(1, 1), b3 + hstep, voffB); PG8_STAGE(PG8_SA(1, 0), a3, voffA);
      PG8_WAIT_V(8); PG8_WAIT_L(0); PG8_BAR; PG8_MMA(1, 0, At, B0); PG8_MMA(1, 1, At, B1); PG8_BAR; PG8_SCHED;
    }
    if (wr == 0) PG8_BAR;
    gemm_epilogue(g, acc, cpm * BM, cpn * BM, wr, wc, fr, fq);
    if (!has_next) break;
#pragma unroll
    for (int a = 0; a < 2; ++a)
#pragma unroll
      for (int b = 0; b < 2; ++b)
#pragma unroll
        for (int m = 0; m < 4; ++m)
#pragma unroll
          for (int n = 0; n < 2; ++n) acc[a][b][m][n] = (f32x4){0.f, 0.f, 0.f, 0.f};
    cpm = npm; cpn = npn; cA = nA; cB = nB; ++ui;
    if (wr == 1) PG8_BAR;
  }
  PG8_WAIT_V(0);
  PG8_BAR;
}

template <int R> DI void conv_row(f32x2 (&acc)[32], const f32x2 (&wt)[31], const unsigned* tile, int tid) {
  const unsigned x = tile[R * 512 + tid];
  const f32x2 xv = {bflo(x), bfhi(x)};
#pragma unroll
  for (int i = 0; i < 32; ++i) { if (R - i >= 0 && R - i < 31) acc[i] = acc[i] + xv * wt[(R - i >= 0 && R - i < 31) ? R - i : 0]; }
  if ((R & 7) == 7) asm volatile("" ::: "memory");
}
template <int R0, int N> struct ConvRows {
  static DI void run(f32x2 (&acc)[32], const f32x2 (&wt)[31], const unsigned* tile, int tid) { conv_row<R0>(acc, wt, tile, tid); ConvRows<R0 + 1, N - 1>::run(acc, wt, tile, tid); }
};
template <int R0> struct ConvRows<R0, 0> { static DI void run(f32x2 (&)[32], const f32x2 (&)[31], const unsigned*, int) {} };
DI void conv_phase(const bf16_t* hc, bf16_t* hn, char* lds) {
  const float* wdw = KP(conv_w_dw);
  const int tid = otid();
  unsigned* tile = (unsigned*)lds;
  float* red = (float*)lds;
  unsigned toff = 131072; asm volatile("" : "+s"(toff));
  float* tot = (float*)(lds + toff);
  const f32x2 bdw = gld<f32x2>(KP(conv_b_dw) + 2 * tid);
  const f32x2 lg = gld<f32x2>(KP(conv_ln_g) + 2 * tid), lb = gld<f32x2>(KP(conv_ln_b) + 2 * tid);
  for (int item = blockIdx.x; item < T_ / 32; item += gridDim.x) {
    const int b = item >> 8, t0 = (item & 255) * 32;
    __syncthreads();
#pragma unroll
    for (int hf = 0; hf < 2; ++hf) {
      u32x4 w[8];
#pragma unroll
      for (int i = 0; i < 8; ++i) {
        const int c = tid + 512 * (8 * hf + i), r = c >> 7, ch = c & 127, t = t0 - 15 + r;
        w[i] = (u32x4){0u, 0u, 0u, 0u};
        if (r < 62 && t >= 0 && t < L_) w[i] = gld<u32x4>(hc + ((size_t)(b * L_ + t)) * 1024 + ch * 8);
      }
#pragma unroll
      for (int i = 0; i < 8; ++i) {
        const int c = tid + 512 * (8 * hf + i), r = c >> 7, ch = c & 127;
        if (r < 62) *(u32x4*)(tile + r * 512 + ch * 4) = w[i];
      }
      asm volatile("" ::: "memory");
    }
    __syncthreads();
    const float* wd2 = wdw; asm volatile("" : "+s"(wd2));
    f32x2 acc[32], wt[31];
#pragma unroll
    for (int i = 0; i < 32; ++i) acc[i] = bdw;
#pragma unroll
    for (int j = 0; j < 31; ++j) wt[j] = gld<f32x2>(wd2 + j * 1024 + 2 * tid);
    ConvRows<0, 62>::run(acc, wt, tile, tid);
    __syncthreads();
#pragma unroll
    for (int i = 0; i < 32; ++i) { red[i * 512 + tid] = acc[i].x + acc[i].y; red[(32 + i) * 512 + tid] = acc[i].x * acc[i].x + acc[i].y * acc[i].y; }
    __syncthreads();
    {
      const int q = tid >> 3, part = tid & 7;
      float sm = 0.f;
#pragma unroll
      for (int i = 0; i < 16; ++i) { f32x4 v = *(const f32x4*)(red + q * 512 + part * 64 + i * 4); sm += (v[0] + v[1]) + (v[2] + v[3]); }
      sm += __shfl_xor(sm, 1); sm += __shfl_xor(sm, 2); sm += __shfl_xor(sm, 4);
      if (part == 0) tot[q] = sm;
    }
    __syncthreads();
#pragma unroll
    for (int i = 0; i < 32; ++i) {
      const float mu = tot[i] * (1.0f / 1024.0f), var = fmaxf(tot[32 + i] * (1.0f / 1024.0f) - mu * mu, 0.f), rstd = rsqrtf(var + EPS);
      float y0 = (acc[i].x - mu) * rstd * lg.x + lb.x, y1 = (acc[i].y - mu) * rstd * lg.y + lb.y;
      y0 = y0 * sigmoidf_(y0); y1 = y1 * sigmoidf_(y1);
      gst<unsigned>(hn + ((size_t)(b * L_ + t0 + i)) * 1024 + 2 * tid, pk(y0, y1));
    }
  }
}

DI void glaprep_phase(const bf16_t* qk, const float* t1, bf16_t* QKf, bf16_t* QKb, float* E, char* lds) {
  const int tid = otid();
  float* t1s = (float*)lds;
  bf16_t* raw = (bf16_t*)(lds + 8192);
  float w2f[16], w2b[16];
  const float* gw2 = KP(gla_w2); const float* ggb = KP(gla_gb);
#pragma unroll
  for (int r = 0; r < 16; ++r) { w2f[r] = gld<float>(gw2 + r * 512 + tid); w2b[r] = gld<float>(gw2 + (16 + r) * 512 + tid); }
  const float bf_ = gld<float>(ggb + tid), bb_ = gld<float>(ggb + 512 + tid);
  for (int item = blockIdx.x; item < T_ / 64; item += gridDim.x) {
    const size_t tok0 = (size_t)item * 64;
    __syncthreads();
    {
      u32x4 w[16];
#pragma unroll
      for (int i = 0; i < 16; ++i) w[i] = gld<u32x4>(qk + tok0 * 1024 + (size_t)(tid + 512 * i) * 8);
      const f32x4 tv = gld<f32x4>(t1 + tok0 * 32 + tid * 4);
#pragma unroll
      for (int i = 0; i < 16; ++i) *(u32x4*)(raw + (size_t)(tid + 512 * i) * 8) = w[i];
      *(f32x4*)(t1s + tid * 4) = tv;
    }
    __syncthreads();
    float c = 0.f;
#pragma unroll 8
    for (int i = 0; i < 64; ++i) {
      float lgt = bf_;
#pragma unroll
      for (int r = 0; r < 16; ++r) lgt += t1s[i * 32 + r] * w2f[r];
      c += log_sigmoid_(lgt) * (1.0f / 16.0f);
      const float qv = bf1(raw[i * 1024 + tid]), kv = bf1(raw[i * 1024 + 512 + tid]);
      gst<bf16_t>(QKf + (tok0 + i) * 1024 + tid, tobf(qv * __expf(c)));
      gst<bf16_t>(QKf + (tok0 + i) * 1024 + 512 + tid, tobf(kv * __expf(-c)));
    }
    gst<float>(E + (size_t)item * 512 + tid, __expf(c));
    c = 0.f;
#pragma unroll 8
    for (int i = 63; i >= 0; --i) {
      float lgt = bb_;
#pragma unroll
      for (int r = 0; r < 16; ++r) lgt += t1s[i * 32 + 16 + r] * w2b[r];
      c += log_sigmoid_(lgt) * (1.0f / 16.0f);
      const float qv = bf1(raw[i * 1024 + tid]), kv = bf1(raw[i * 1024 + 512 + tid]);
      gst<bf16_t>(QKb + (tok0 + i) * 1024 + tid, tobf(qv * __expf(c)));
      gst<bf16_t>(QKb + (tok0 + i) * 1024 + 512 + tid, tobf(kv * __expf(-c)));
    }
    gst<float>(E + (size_t)(T_ / 64) * 512 + (size_t)item * 512 + tid, __expf(c));
  }
}

template <int DK, bool GLA>
DI void ppass_phase(const bf16_t* Qf, const bf16_t* Kf, const bf16_t* Qb, const bf16_t* Kb, int ld, const float* decay, bf16_t* P) {
  const int tid_ = otid(), wid = tid_ >> 6, lane = tid_ & 63, fr = lane & 15, fq = lane >> 4;
  const int rt = wid >> 1, ct0 = 2 * (wid & 1);
  for (int item = blockIdx.x; item < 2048; item += gridDim.x) {
    const int n = item & 127, h = (item >> 7) & 3, b = item >> 9;
    const size_t tok0 = (size_t)b * L_ + n * 64;
    f32x4 xf[2] = {}, xb[2] = {};
    const bf16_t* qa = Qf + (tok0 + 16 * rt + fr) * ld + h * DK + 8 * fq;
    const bf16_t* ka0 = Kf + (tok0 + 16 * ct0 + fr) * ld + h * DK + 8 * fq;
    const bf16_t* ka1 = ka0 + (size_t)16 * ld;
#pragma unroll
    for (int kk = 0; kk < DK / 32; ++kk) {
      const bf16x8 a = gld<bf16x8>(qa + 32 * kk), b0 = gld<bf16x8>(ka0 + 32 * kk), b1 = gld<bf16x8>(ka1 + 32 * kk);
      xf[0] = __builtin_amdgcn_mfma_f32_16x16x32_bf16(a, b0, xf[0], 0, 0, 0);
      xf[1] = __builtin_amdgcn_mfma_f32_16x16x32_bf16(a, b1, xf[1], 0, 0, 0);
    }
    if (GLA) {
      const bf16_t* qb = Qb + (tok0 + 16 * rt + fr) * ld + h * DK + 8 * fq;
      const bf16_t* kb0 = Kb + (tok0 + 16 * ct0 + fr) * ld + h * DK + 8 * fq;
      const bf16_t* kb1 = kb0 + (size_t)16 * ld;
#pragma unroll
      for (int kk = 0; kk < DK / 32; ++kk) {
        const bf16x8 a = gld<bf16x8>(qb + 32 * kk), b0 = gld<bf16x8>(kb0 + 32 * kk), b1 = gld<bf16x8>(kb1 + 32 * kk);
        xb[0] = __builtin_amdgcn_mfma_f32_16x16x32_bf16(a, b0, xb[0], 0, 0, 0);
        xb[1] = __builtin_amdgcn_mfma_f32_16x16x32_bf16(a, b1, xb[1], 0, 0, 0);
      }
    }
    bf16_t* Po = P + (size_t)item * 4096;
    Po = P + ((size_t)((b * 128 + n) * 4 + h)) * 4096;
#pragma unroll
    for (int c = 0; c < 2; ++c)
#pragma unroll
      for (int j = 0; j < 4; ++j) {
        const int i = 16 * rt + 4 * fq + j, s = 16 * (ct0 + c) + fr;
        float v;
        if (GLA) v = (s <= i) ? xf[c][j] : xb[c][j];
        else v = xf[c][j];
        gst<bf16_t>(Po + i * 64 + s, tobf(v));
      }
  }
}

struct FalseC { static constexpr bool value = false; }; struct TrueC { static constexpr bool value = true; };
struct ScanArgs {
  const bf16_t* q0; const bf16_t* q1; const bf16_t* k0; const bf16_t* k1;
  const bf16_t* v; const bf16_t* P; bf16_t* o;
  const float* E;
  const float* decay;
  float* ssp;
};
DI s16x4 tr_read(unsigned a) { s16x4 r; asm volatile("ds_read_b64_tr_b16 %0, %1\n\ts_waitcnt lgkmcnt(0)" : "=&v"(r) : "v"(a) : "memory"); return r; }
template <int SA_, int SB_>
DI void tr_read8(unsigned a, s16x4 (&r)[8]) {
  asm volatile("ds_read_b64_tr_b16 %0, %8 offset:%9\n\tds_read_b64_tr_b16 %1, %8 offset:%10\n\tds_read_b64_tr_b16 %2, %8 offset:%11\n\tds_read_b64_tr_b16 %3, %8 offset:%12\n\t"
               "ds_read_b64_tr_b16 %4, %8 offset:%13\n\tds_read_b64_tr_b16 %5, %8 offset:%14\n\tds_read_b64_tr_b16 %6, %8 offset:%15\n\tds_read_b64_tr_b16 %7, %8 offset:%16\n\t"
               "s_waitcnt lgkmcnt(0)"
               : "=&v"(r[0]), "=&v"(r[1]), "=&v"(r[2]), "=&v"(r[3]), "=&v"(r[4]), "=&v"(r[5]), "=&v"(r[6]), "=&v"(r[7])
               : "v"(a), "n"(0), "n"(SA_), "n"(SB_), "n"(SB_ + SA_), "n"(2 * SB_), "n"(2 * SB_ + SA_), "n"(3 * SB_), "n"(3 * SB_ + SA_)
               : "memory");
}
template <int SA_, int SB_>
DI void tr_issue8(unsigned a, s16x4 (&r)[8]) {
  asm volatile("ds_read_b64_tr_b16 %0, %8 offset:%9\n\tds_read_b64_tr_b16 %1, %8 offset:%10\n\tds_read_b64_tr_b16 %2, %8 offset:%11\n\tds_read_b64_tr_b16 %3, %8 offset:%12\n\t"
               "ds_read_b64_tr_b16 %4, %8 offset:%13\n\tds_read_b64_tr_b16 %5, %8 offset:%14\n\tds_read_b64_tr_b16 %6, %8 offset:%15\n\tds_read_b64_tr_b16 %7, %8 offset:%16"
               : "=&v"(r[0]), "=&v"(r[1]), "=&v"(r[2]), "=&v"(r[3]), "=&v"(r[4]), "=&v"(r[5]), "=&v"(r[6]), "=&v"(r[7])
               : "v"(a), "n"(0), "n"(SA_), "n"(SB_), "n"(SB_ + SA_), "n"(2 * SB_), "n"(2 * SB_ + SA_), "n"(3 * SB_), "n"(3 * SB_ + SA_)
               : "memory");
}
DI void tr_wait8(s16x4 (&a)[8]) {
  asm volatile("s_waitcnt lgkmcnt(0)" : "+v"(a[0]), "+v"(a[1]), "+v"(a[2]), "+v"(a[3]), "+v"(a[4]), "+v"(a[5]), "+v"(a[6]), "+v"(a[7]) :: "memory");
}
DI void tr_wait16(s16x4 (&a)[8], s16x4 (&b)[8]) {
  asm volatile("s_waitcnt lgkmcnt(0)" : "+v"(a[0]), "+v"(a[1]), "+v"(a[2]), "+v"(a[3]), "+v"(a[4]), "+v"(a[5]), "+v"(a[6]), "+v"(a[7]),
               "+v"(b[0]), "+v"(b[1]), "+v"(b[2]), "+v"(b[3]), "+v"(b[4]), "+v"(b[5]), "+v"(b[6]), "+v"(b[7]) :: "memory");
}
DI bf16x8 cat8(s16x4 a, s16x4 b) { bf16x8 r; r[0] = a[0]; r[1] = a[1]; r[2] = a[2]; r[3] = a[3]; r[4] = b[0]; r[5] = b[1]; r[6] = b[2]; r[7] = b[3]; return r; }
DI u32x4 scale8(u32x4 w, float s) {
  u32x4 r; r.x = pk(bflo(w.x) * s, bfhi(w.x) * s); r.y = pk(bflo(w.y) * s, bfhi(w.y) * s); r.z = pk(bflo(w.z) * s, bfhi(w.z) * s); r.w = pk(bflo(w.w) * s, bfhi(w.w) * s); return r;
}
template <int DK>
DI void scan_phase(const ScanArgs& a, char* lds, const XcdBarrier& xb) {
  constexpr int QS = DK * 2 + 16, KS = DK * 2 + 64, VS = 192, PS = 144, NQ = DK / 128 * 2;
  constexpr int RW = DK / 4, NT = RW / 32;
  constexpr int LDQK = (DK == 256) ? 2048 : 1024, LDV = LDQK, LDO = LDQK, DVH = 2 * DK;
  constexpr bool ret = (DK == 256);
  constexpr int OFF_K = 64 * QS, OFF_V = OFF_K + 64 * KS, OFF_PP = OFF_V + 64 * VS, OFF_O = OFF_PP + 64 * PS, OFF_EE = OFF_O + 65536, OFF_SC = OFF_EE + DK * 4;
  static_assert(OFF_SC + 512 <= (int)LDS_BYTES - 16, "LDS budget");
  const int tid = otid(), wid = tid >> 6, lane = tid & 63, wr = __builtin_amdgcn_readfirstlane(wid >> 1), wc = __builtin_amdgcn_readfirstlane(wid & 1);
  const int r = lane & 31, hh = lane >> 5, g1 = (lane >> 4) & 1, i16 = lane & 15, qd = i16 >> 2, pp = i16 & 3;
  const unsigned ldsb = (unsigned)(uintptr_t)lds;
  float* qsc = (float*)(lds + OFF_SC); float* ksc = qsc + 64;
  constexpr int NS = DVH >> 6, nitems = 32 * NS;
  const int bid = obid(), xcd = bid & 7, inx = bid >> 3;
  const bool g256 = (gridDim.x == 256);
  const bool active = g256 ? (inx < 4 * NS) : (bid < nitems);
  const int item = g256 ? ((xcd * 4 + inx / NS) * NS + inx % NS) : bid;
  const int slice = item % NS, dir = (item / NS) & 1, h = (item / (2 * NS)) & 3, b = item / (8 * NS);
  float econst = 1.f;
  if (active && ret) {
    const float lg = log_sigmoid_(gld<float>(a.decay + dir * 4 + h));
    econst = __expf(64.f * lg);
    if (tid < 64) { const float e = dir ? (float)(64 - tid) : (float)(tid + 1); qsc[tid] = __expf(lg * e); ksc[tid] = __expf(-lg * e); }
  }
  __syncthreads();
  const bf16_t* qg = (dir ? a.q1 : a.q0) + (size_t)b * L_ * LDQK + h * DK;
  const bf16_t* kg = (dir ? a.k1 : a.k0) + (size_t)b * L_ * LDQK + h * DK;
  const bf16_t* vg = a.v + (size_t)b * L_ * LDV + h * DVH + slice * 64;
  bf16_t* og = a.o + (size_t)b * L_ * LDO + h * DVH + slice * 64;
  const bf16_t* pg = a.P + ((size_t)(b * 128) * 4 + h) * 4096;
  const float* eg = ret ? nullptr : (a.E + (size_t)dir * (T_ / 64) * (4 * DK) + (size_t)(b * 128) * (4 * DK) + h * DK);
  f32x16 S[NT];
#pragma unroll
  for (int j = 0; j < NT; ++j)
#pragma unroll
    for (int e = 0; e < 16; ++e) S[j][e] = 0.f;
  struct Regs { u32x4 q[NQ], k[NQ], v, p; };
  Regs RA, RB;
  constexpr int DEPTH = (DK == 128) ? 2 : 1;
  float enext = 1.f;
  const int vrow = tid >> 3, vch = tid & 7;
  auto chunk_of = [&](int st) { const int s2 = st < 128 ? st : 127; return dir ? 127 - s2 : s2; };
  auto issue = [&](Regs& R, int n) {
    const size_t t0 = (size_t)n * 64;
#pragma unroll
    for (int i = 0; i < NQ; ++i) {
      const int c = tid + 512 * i, row = c / (DK / 8), ch = c % (DK / 8);
      R.q[i] = gld<u32x4>(qg + (t0 + row) * LDQK + ch * 8);
      R.k[i] = gld<u32x4>(kg + (t0 + row) * LDQK + ch * 8);
    }
    R.v = gld<u32x4>(vg + (t0 + vrow) * LDV + vch * 8);
    R.p = gld<u32x4>(pg + (size_t)n * 4 * 4096 + vrow * 64 + vch * 8);
  };
  auto issue1 = [&](int n1) { if (!ret) enext = gld<float>(eg + (size_t)n1 * (4 * DK) + (tid < DK ? tid : 0)); };
  auto step_fn = [&](Regs& R, int step, auto second_c) {
    constexpr bool second = decltype(second_c)::value;
    const int n = dir ? 127 - step : step;
    u32x4 ocur = {0u, 0u, 0u, 0u};
    if (second) ocur = gld<u32x4>(og + ((size_t)n * 64 + vrow) * LDO + vch * 8);
#pragma unroll
    for (int i = 0; i < NQ; ++i) {
      const int c = tid + 512 * i, row = c / (DK / 8), ch = c % (DK / 8);
      *(u32x4*)(lds + row * QS + ch * 16) = R.q[i];
      *(u32x4*)(lds + OFF_K + row * KS + ch * 16) = R.k[i];
    }
    *(u32x4*)(lds + OFF_V + vrow * VS + vch * 16) = ret ? scale8(R.v, ksc[vrow]) : R.v;
    {
      u32x4 w = R.p; unsigned ww[4] = {w.x, w.y, w.z, w.w};
#pragma unroll
      for (int e = 0; e < 4; ++e) {
        const int s0 = vch * 8 + 2 * e, s1 = s0 + 1;
        const bool k0 = dir ? (s0 > vrow) : (s0 <= vrow), k1 = dir ? (s1 > vrow) : (s1 <= vrow);
        ww[e] = (k0 ? (ww[e] & 0xffffu) : 0u) | (k1 ? (ww[e] & 0xffff0000u) : 0u);
      }
      *(u32x4*)(lds + OFF_PP + vrow * PS + vch * 16) = (u32x4){ww[0], ww[1], ww[2], ww[3]};
    }
    if (!ret) { if (tid < DK) *(float*)(lds + OFF_EE + tid * 4) = enext; }
    lds_barrier();
    issue(R, chunk_of(step + DEPTH));
    issue1(chunk_of(step + 1));
    bf16x8 vf[4];
    bf16x8 qa[2][2];
    auto ldq = [&](int jk, bf16x8 (&dst)[2]) {
      const int j = jk >> 1, ks = jk & 1;
#pragma unroll
      for (int tt = 0; tt < 2; ++tt) {
        const char* qp = lds + (32 * tt + r) * QS + (wr * RW + 32 * j + 16 * ks + 4 * hh) * 2;
        dst[tt] = cat8(*(const s16x4*)qp, *(const s16x4*)(qp + 16));
      }
    };
    f32x16 oacc[2];
    const f32x16 zero16 = {0.f, 0.f, 0.f, 0.f, 0.f, 0.f, 0.f, 0.f, 0.f, 0.f, 0.f, 0.f, 0.f, 0.f, 0.f, 0.f};
    {
      s16x4 t8[8];
      tr_issue8<4 * VS, 16 * VS>(ldsb + OFF_V + (8 * hh + qd) * VS + (32 * wc + 16 * g1 + 4 * pp) * 2, t8);
      const bf16x8 pa0 = *(const bf16x8*)(lds + OFF_PP + r * PS + (16 * wr + 8 * hh) * 2);
      const bf16x8 pa1 = *(const bf16x8*)(lds + OFF_PP + (32 + r) * PS + (16 * wr + 8 * hh) * 2);
      ldq(0, qa[0]);
      tr_wait8(t8);
#pragma unroll
      for (int s4 = 0; s4 < 4; ++s4) vf[s4] = cat8(t8[2 * s4], t8[2 * s4 + 1]);
      if (wr == 0) { oacc[0] = __builtin_amdgcn_mfma_f32_32x32x16_bf16(pa0, vf[0], zero16, 0, 0, 0); oacc[1] = __builtin_amdgcn_mfma_f32_32x32x16_bf16(pa1, vf[0], zero16, 0, 0, 0); }
      else if (wr == 1) { oacc[0] = __builtin_amdgcn_mfma_f32_32x32x16_bf16(pa0, vf[1], zero16, 0, 0, 0); oacc[1] = __builtin_amdgcn_mfma_f32_32x32x16_bf16(pa1, vf[1], zero16, 0, 0, 0); }
      else if (wr == 2) { oacc[0] = __builtin_amdgcn_mfma_f32_32x32x16_bf16(pa0, vf[2], zero16, 0, 0, 0); oacc[1] = __builtin_amdgcn_mfma_f32_32x32x16_bf16(pa1, vf[2], zero16, 0, 0, 0); }
      else { oacc[0] = __builtin_amdgcn_mfma_f32_32x32x16_bf16(pa0, vf[3], zero16, 0, 0, 0); oacc[1] = __builtin_amdgcn_mfma_f32_32x32x16_bf16(pa1, vf[3], zero16, 0, 0, 0); }
    }
#pragma unroll
    for (int jk = 0; jk < 2 * NT; ++jk) {
      if (jk + 1 < 2 * NT) ldq(jk + 1, qa[(jk + 1) & 1]);
      __builtin_amdgcn_sched_barrier(0);
      const int j = jk >> 1, ks = jk & 1;
      u32x4 sb;
      sb.x = pk(S[j][8 * ks + 0], S[j][8 * ks + 1]); sb.y = pk(S[j][8 * ks + 2], S[j][8 * ks + 3]);
      sb.z = pk(S[j][8 * ks + 4], S[j][8 * ks + 5]); sb.w = pk(S[j][8 * ks + 6], S[j][8 * ks + 7]);
      const bf16x8 bfr = __builtin_bit_cast(bf16x8, sb);
      oacc[0] = __builtin_amdgcn_mfma_f32_32x32x16_bf16(qa[jk & 1][0], bfr, oacc[0], 0, 0, 0);
      oacc[1] = __builtin_amdgcn_mfma_f32_32x32x16_bf16(qa[jk & 1][1], bfr, oacc[1], 0, 0, 0);
      __builtin_amdgcn_sched_barrier(0);
    }
#pragma unroll
    for (int tt = 0; tt < 2; ++tt)
#pragma unroll
      for (int e = 0; e < 16; ++e) {
        const int t = 32 * tt + (e & 3) + 8 * (e >> 2) + 4 * hh;
        *(float*)(lds + OFF_O + ((wr * 64 + t) * 64 + 32 * wc + r) * 4) = oacc[tt][e];
      }
    {
      s16x4 ka[8], kb[8];
      tr_issue8<4 * KS, 16 * KS>(ldsb + OFF_K + (8 * hh + qd) * KS + (wr * RW + 16 * g1 + 4 * pp) * 2, ka);
      if (NT == 2) tr_issue8<4 * KS, 16 * KS>(ldsb + OFF_K + (8 * hh + qd) * KS + (wr * RW + 32 + 16 * g1 + 4 * pp) * 2, kb);
      if (NT == 2) tr_wait16(ka, kb); else tr_wait8(ka);
#pragma unroll
      for (int s4 = 0; s4 < 4; ++s4) {
        S[0] = __builtin_amdgcn_mfma_f32_32x32x16_bf16(cat8(ka[2 * s4], ka[2 * s4 + 1]), vf[s4], S[0], 0, 0, 0);
        if (NT == 2) S[NT - 1] = __builtin_amdgcn_mfma_f32_32x32x16_bf16(cat8(kb[2 * s4], kb[2 * s4 + 1]), vf[s4], S[NT - 1], 0, 0, 0);
      }
    }
#pragma unroll
    for (int j = 0; j < NT; ++j) {
      if (ret) {
#pragma unroll
        for (int e = 0; e < 16; ++e) S[j][e] *= econst;
      } else {
#pragma unroll
        for (int gq = 0; gq < 4; ++gq) {
          const f32x4 ev = *(const f32x4*)(lds + OFF_EE + (wr * RW + 32 * j + 8 * gq + 4 * hh) * 4);
#pragma unroll
          for (int e = 0; e < 4; ++e) S[j][4 * gq + e] *= ev[e];
        }
      }
    }
    lds_barrier();
    {
      float sum[8];
#pragma unroll
      for (int e = 0; e < 8; ++e) sum[e] = 0.f;
#pragma unroll
      for (int w4 = 0; w4 < 4; ++w4) {
        const float* op = (const float*)(lds + OFF_O + ((w4 * 64 + vrow) * 64 + vch * 8) * 4);
        const f32x4 x0 = *(const f32x4*)op, x1 = *(const f32x4*)(op + 4);
        sum[0] += x0[0]; sum[1] += x0[1]; sum[2] += x0[2]; sum[3] += x0[3]; sum[4] += x1[0]; sum[5] += x1[1]; sum[6] += x1[2]; sum[7] += x1[3];
      }
      if (ret) {
        const float myqs = qsc[vrow];
#pragma unroll
        for (int e = 0; e < 8; ++e) sum[e] *= myqs;
      }
      if (second) {
        sum[0] += bflo(ocur.x); sum[1] += bfhi(ocur.x); sum[2] += bflo(ocur.y); sum[3] += bfhi(ocur.y);
        sum[4] += bflo(ocur.z); sum[5] += bfhi(ocur.z); sum[6] += bflo(ocur.w); sum[7] += bfhi(ocur.w);
      }
      u32x4 w; w.x = pk(sum[0], sum[1]); w.y = pk(sum[2], sum[3]); w.z = pk(sum[4], sum[5]); w.w = pk(sum[6], sum[7]);
      gst<u32x4>(og + ((size_t)n * 64 + vrow) * LDO + vch * 8, w);
      if (second) {
        float q2 = bflo(w.x) * bflo(w.x) + bfhi(w.x) * bfhi(w.x) + bflo(w.y) * bflo(w.y) + bfhi(w.y) * bfhi(w.y) +
                   bflo(w.z) * bflo(w.z) + bfhi(w.z) * bfhi(w.z) + bflo(w.w) * bflo(w.w) + bfhi(w.w) * bfhi(w.w);
        q2 += __shfl_xor(q2, 1); q2 += __shfl_xor(q2, 2); q2 += __shfl_xor(q2, 4);
        if (vch == 0) gst<float>(a.ssp + ((size_t)b * L_ + (size_t)n * 64 + vrow) * 32 + h * 8 + slice, q2);
      }
    }
  };
  if (active) {
    issue(RA, chunk_of(0)); issue1(chunk_of(0));
    if (DEPTH == 2) {
      issue(RB, chunk_of(1));
      for (int step = 0; step < 64; step += 2) { step_fn(RA, step, FalseC{}); step_fn(RB, step + 1, FalseC{}); }
    } else {
      for (int step = 0; step < 64; ++step) step_fn(RA, step, FalseC{});
    }
  }
  xcd_barrier(xb);
  if (active) {
    if (DEPTH == 2) {
      for (int step = 64; step < 128; step += 2) { step_fn(RA, step, TrueC{}); step_fn(RB, step + 1, TrueC{}); }
    } else {
      for (int step = 64; step < 128; ++step) step_fn(RA, step, TrueC{});
    }
  }
}

__global__ void __launch_bounds__(512, 2) mega(Params p) {
  cg::grid_group grid = cg::this_grid();
  extern __shared__ __attribute__((aligned(16))) char lds[];
  char* ws = KP(ws);
  volatile LAS unsigned* xst = (volatile LAS unsigned*)(LAS char*)(lds + (LDS_BYTES - 16));
  if (threadIdx.x == 0) { xst[0] = 0u; xst[1] = 0u; }
  __syncthreads();
  XcdBarrier xb = xcd_barrier_post((unsigned*)(ws + OFF_BAR), xst);
  rw_phase(KP(x), (bf16_t*)(ws + OFF_D), nullptr, nullptr, (float*)(ws + OFF_RS + 512 * 1024), nullptr, false);
  wconv_layer(0, (float*)lds);
  if (gridDim.x == 0x7fffffffu) grid.sync();
  xcd_barrier(xb);

  for (int layer = 0; layer < 4; ++layer) {
    const int kind0 = layer % 3;
    const int nsteps = (kind0 == 0 ? 6 : kind0 == 1 ? 4 : 7) + 3;
    const int nmix = nsteps - 3;
    for (int s = 0; s < nsteps; ++s) {
      int lyr = layer; asm volatile("" : "+s"(lyr));
      const int kind = (lyr == 3) ? 0 : lyr;
      char* ws = KP(ws);
      bf16_t* W = (bf16_t*)(ws + OFF_W);
      bf16_t* bA = (bf16_t*)(ws + OFF_A); bf16_t* bB = (bf16_t*)(ws + OFF_B); bf16_t* bC = (bf16_t*)(ws + OFF_C); bf16_t* bU = (bf16_t*)(ws + OFF_D);
      bf16_t* bP = (bf16_t*)(ws + OFF_P);
      float* rs = (float*)(ws + OFF_RS); float* Eb = (float*)(ws + OFF_E); float* t1 = (float*)(ws + OFF_T1);
      float* rh = (float*)(ws + OFF_RS + 512 * 1024);
      const float* G = KP(norm_gains);
      const float* gl = G + lyr * 4096;
      GemmDesc g{}; bool is_gemm = false;

      const int ms = s - nmix;
      if (ms == 0) { is_gemm = true; g.A = bU; g.Bt = W + W_UP; g.N = 4096; g.K = 1024; g.epi = EPI_RELU2; g.o0 = bA; g.rowscale = nullptr; }
      else if (ms == 1) { is_gemm = true; g.A = bA; g.Bt = W + W_DN; g.N = 1024; g.K = 4096; g.epi = EPI_PLAIN; g.o0 = bC; }
      else if (ms == 2) {
        rw_phase(nullptr, bU, bC, gl + 3072, rh, (lyr < 3) ? nullptr : KP(out), true);
        if (lyr < 3) wconv_layer(lyr + 1, (float*)lds);
      } else if (kind == 0) {
        const float* dec = KP(ret_decay) + (lyr / 3) * 8;
        if (s == 0) { is_gemm = true; g.A = bU; g.Bt = W + W_IN; g.N = 4096; g.K = 1024; g.epi = EPI_RETQKV; g.o0 = bA; g.o1 = bB; g.pos = KP(pos); g.rowscale = rh; }
        else if (s == 1) ppass_phase<256, false>(bA, bA + 1024, nullptr, nullptr, 2048, dec, bP);
        else if (s == 2) {
          ScanArgs a{}; a.q0 = a.q1 = bA; a.k0 = a.k1 = bA + 1024; a.v = bB; a.P = bP; a.o = bC;
          a.E = nullptr; a.decay = dec; a.ssp = t1;
          scan_phase<256>(a, lds, xb);
        }
        else if (s == 3) { is_gemm = true; g.A = bU; g.Bt = W + W_G; g.N = 2048; g.K = 1024; g.epi = EPI_GATE; g.dvshift = 9; g.o0 = bC; g.f0 = t1; g.c0 = nullptr; g.rowscale = rh; }
        else if (s == 4) { is_gemm = true; g.A = bC; g.Bt = W + W_OUT; g.N = 1024; g.K = 2048; g.epi = EPI_PLAIN; g.o0 = bA; }
        else rw_phase(nullptr, bU, bA, gl + 1024, rh, nullptr, false);
      } else if (kind == 1) {
        if (s == 0) { is_gemm = true; g.A = bU; g.Bt = W + W_IN; g.N = 2048; g.K = 1024; g.epi = EPI_GLU; g.o0 = bA; g.bias = KP(conv_b_in); g.rowscale = rh; }
        else if (s == 1) conv_phase(bA, bB, lds);
        else if (s == 2) { is_gemm = true; g.A = bB; g.Bt = W + W_OUT; g.N = 1024; g.K = 1024; g.epi = EPI_PLAIN; g.o0 = bC; g.bias = KP(conv_b_out); }
        else rw_phase(nullptr, bU, bC, gl + 1024, rh, nullptr, false);
      } else {
        bf16_t* gv = bA + (size_t)T_ * 1024; bf16_t* qkb = bB + (size_t)T_ * 1024; bf16_t* gy = bC + (size_t)T_ * 1024;
        if (s == 0) { is_gemm = true; g.A = bU; g.Bt = W + W_IN; g.N = 2304; g.K = 1024; g.epi = EPI_GLA; g.o0 = bA; g.o1 = gv; g.f0 = t1; g.rowscale = rh; }
        else if (s == 1) glaprep_phase(bA, t1, bB, qkb, Eb, lds);
        else if (s == 2) ppass_phase<128, true>(bB, bB + 512, qkb, qkb + 512, 1024, nullptr, bP);
        else if (s == 3) {
          ScanArgs a{}; a.q0 = bB; a.k0 = bB + 512; a.q1 = qkb; a.k1 = qkb + 512; a.v = gv; a.P = bP; a.o = bC;
          a.E = Eb; a.decay = nullptr; a.ssp = t1;
          scan_phase<128>(a, lds, xb);
        }
        else if (s == 4) { is_gemm = true; g.A = bU; g.Bt = W + W_G; g.N = 1024; g.K = 1024; g.epi = EPI_GATE; g.dvshift = 8; g.o0 = bC; g.f0 = t1; g.c0 = KP(gla_ng); g.rowscale = rh; }
        else if (s == 5) { is_gemm = true; g.A = bC; g.Bt = W + W_OUT; g.N = 1024; g.K = 1024; g.epi = EPI_PLAIN; g.o0 = gy; }
        else rw_phase(nullptr, bU, gy, gl + 1024, rh, nullptr, false);
      }
      if (is_gemm) gemm_phase(g, (LAS unsigned char*)lds);
      xcd_barrier(xb);
    }
  }
}

extern "C" void kernel_launch(void* const* d_in, const int* in_sizes, int n_in, void* d_out, int out_size,
                              void* d_ws, size_t ws_size, hipStream_t stream) {
  static int grid_blocks = 0;
  if (!grid_blocks) {
    (void)hipFuncSetAttribute((const void*)mega, hipFuncAttributeMaxDynamicSharedMemorySize, (int)LDS_BYTES);
    int dev = 0, cus = 0;
    (void)hipGetDevice(&dev);
    (void)hipDeviceGetAttribute(&cus, hipDeviceAttributeMultiprocessorCount, dev);
    grid_blocks = cus;
  }
  if (ws_size < 505 * MiB) { fprintf(stderr, "workspace too small: %zu\n", ws_size); return; }
  Params p{};
  p.x = (const float*)d_in[0]; p.pos = (const int*)d_in[1]; p.norm_gains = (const float*)d_in[2];
  p.ret_w_in = (const float*)d_in[3]; p.ret_decay = (const float*)d_in[4]; p.ret_w_out = (const float*)d_in[5];
  p.conv_w_in = (const float*)d_in[6]; p.conv_b_in = (const float*)d_in[7]; p.conv_w_dw = (const float*)d_in[8]; p.conv_b_dw = (const float*)d_in[9];
  p.conv_ln_g = (const float*)d_in[10]; p.conv_ln_b = (const float*)d_in[11]; p.conv_w_out = (const float*)d_in[12]; p.conv_b_out = (const float*)d_in[13];
  p.gla_w_in = (const float*)d_in[14]; p.gla_w1 = (const float*)d_in[15]; p.gla_w2 = (const float*)d_in[16]; p.gla_gb = (const float*)d_in[17];
  p.gla_ng = (const float*)d_in[18]; p.gla_w_out = (const float*)d_in[19]; p.mlp_up = (const float*)d_in[20]; p.mlp_down = (const float*)d_in[21];
  p.out = (float*)d_out; p.ws = (char*)d_ws;
  (void)hipMemsetAsync((char*)d_ws + OFF_BAR, 0, XCD_BAR_WORDS * 4, stream);
  void* args[] = {&p};
  hipError_t e = hipLaunchCooperativeKernel((void*)mega, dim3(grid_blocks), dim3(512), args, LDS_BYTES, stream);
  if (e != hipSuccess) fprintf(stderr, "cooperative launch failed: %s (grid %d)\n", hipGetErrorString(e), grid_blocks);
}
```

```cpp
#include <hip/hip_runtime.h>
#include <hip/hip_cooperative_groups.h>
#include <cstdio>
#include <cstdint>
namespace cg = cooperative_groups;

#define DI __device__ __forceinline__
typedef unsigned short bf16_t;
typedef short bf16x8 __attribute__((ext_vector_type(8)));
typedef short s16x4 __attribute__((ext_vector_type(4)));
typedef float f32x2 __attribute__((ext_vector_type(2)));
typedef float f32x4 __attribute__((ext_vector_type(4)));
typedef float f32x16 __attribute__((ext_vector_type(16)));
typedef unsigned u32x2 __attribute__((ext_vector_type(2)));
typedef unsigned u32x4 __attribute__((ext_vector_type(4)));
typedef __bf16 bf2_t __attribute__((ext_vector_type(2)));

constexpr int T_ = 32768, L_ = 8192;
constexpr float EPS = 1e-6f;
constexpr size_t MiB = 1u << 20;
constexpr size_t OFF_W = 0, OFF_A = 32 * MiB, OFF_B = 160 * MiB, OFF_C = 288 * MiB, OFF_D = 416 * MiB, OFF_P = 480 * MiB,
                 OFF_RS = 496 * MiB, OFF_E = 497 * MiB, OFF_T1 = 500 * MiB, OFF_BAR = 504 * MiB;
constexpr size_t LDS_BYTES = 163840;

struct Params {
  const float* x; const int* pos; const float* norm_gains;
  const float* ret_w_in; const float* ret_decay; const float* ret_w_out;
  const float* conv_w_in; const float* conv_b_in; const float* conv_w_dw; const float* conv_b_dw; const float* conv_ln_g; const float* conv_ln_b;
  const float* conv_w_out; const float* conv_b_out;
  const float* gla_w_in; const float* gla_w1; const float* gla_w2; const float* gla_gb; const float* gla_ng; const float* gla_w_out;
  const float* mlp_up; const float* mlp_down;
  float* out; char* ws;
};

DI unsigned pk(float lo, float hi) { f32x2 v = {lo, hi}; bf2_t b = __builtin_convertvector(v, bf2_t); return __builtin_bit_cast(unsigned, b); }
DI float bflo(unsigned w) { return __uint_as_float(w << 16); }
DI float bfhi(unsigned w) { return __uint_as_float(w & 0xffff0000u); }
DI float bf1(bf16_t h) { return __uint_as_float(((unsigned)h) << 16); }
DI bf16_t tobf(float f) { return (bf16_t)(pk(f, 0.f) & 0xffffu); }
DI float sigmoidf_(float x) { return 1.0f / (1.0f + __expf(-x)); }
DI const void* karg(int off) {
  const char* kp = (const char*)__builtin_amdgcn_kernarg_segment_ptr();
  const void* r;
  asm volatile("s_load_dwordx2 %0, %1, %2\n\ts_waitcnt lgkmcnt(0)" : "=s"(r) : "s"(kp), "s"(off) : "memory");
  return r;
}
typedef __attribute__((address_space(1))) char gchar_t;
#define KP(f) ((decltype(Params::f))(char*)(gchar_t*)(char*)karg((int)offsetof(Params, f)))
#define GAS __attribute__((address_space(1)))
template <class T> DI T gld(const void* p) { return *(const GAS T*)(const GAS char*)(const char*)p; }
template <class T> DI void gst(void* p, T v) { *(GAS T*)(GAS char*)(char*)p = v; }
DI float log_sigmoid_(float x) {
  const float e = __expf(-fabsf(x));
  const float l1p = (e < 0.0625f) ? e * (1.0f + e * (-0.5f + e * (0.33333334f + e * (-0.25f + e * (0.2f + e * (-0.16666667f + e * 0.14285715f)))))) : __logf(1.0f + e);
  return fminf(x, 0.f) - l1p;
}
DI void lds_barrier() { asm volatile("s_waitcnt lgkmcnt(0)" ::: "memory"); __builtin_amdgcn_s_barrier(); asm volatile("" ::: "memory"); }
DI int obid() { int b = blockIdx.x; asm volatile("" : "+s"(b)); return b; }
DI int otid() { int t = threadIdx.x; asm volatile("" : "+v"(t)); return t; }
DI float wave_sum(float v) {
#pragma unroll
  for (int o = 1; o < 64; o <<= 1) v += __shfl_xor(v, o);
  return v;
}


#define XB_TMO      128
#define XB_XCNT(j)  (256  + 64 * (j))
#define XB_XSUB(j)  (1280 + 64 * (j))
#define XB_XGEN(j)  (2304 + 64 * (j))
#define XB_TOP      3328
#define XB_TOPGEN   3392
#define XCD_BAR_WORDS 3456
#define XB_SPIN_CAP (1u << 18)
#define LAS __attribute__((address_space(3)))
DI unsigned xb_ld(unsigned* p)              { return __hip_atomic_load(p, __ATOMIC_RELAXED, __HIP_MEMORY_SCOPE_AGENT); }
DI unsigned xb_add(unsigned* p, unsigned v) { return __hip_atomic_fetch_add(p, v, __ATOMIC_RELAXED, __HIP_MEMORY_SCOPE_AGENT); }
DI unsigned xb_xcc_id() { return (unsigned)__builtin_amdgcn_s_getreg((3 << 11) | 20) & 0xFu; }
#define XB_SPIN(cond, bar) do { unsigned _sp = 0; while (cond) { __builtin_amdgcn_s_sleep(1); \
    if ((++_sp & 255u) == 0u) { if (xb_ld(&(bar)[XB_TMO])) break; if (_sp > XB_SPIN_CAP) { atomicAdd(&(bar)[XB_TMO], 1u); break; } } } } while (0)
struct XcdBarrier { unsigned* bar; unsigned x; volatile LAS unsigned* st; };
DI XcdBarrier xcd_barrier_post(unsigned* bar, volatile LAS unsigned* st) {
  XcdBarrier b; b.bar = bar; b.x = xb_xcc_id(); b.st = st;
  if (threadIdx.x == 0) (void)xb_add(&bar[XB_XCNT(b.x)], 1u);
  return b;
}
DI void xcd_barrier_complete(unsigned* bar, unsigned x, unsigned& nloc, unsigned& nx) {
  const unsigned G = gridDim.x * gridDim.y * gridDim.z;
  unsigned sum, cnt, mine, sp = 0u;
  for (;;) {
    sum = 0u; cnt = 0u; mine = 0u;
#pragma unroll
    for (unsigned j = 0; j < 16; ++j) { const unsigned c = xb_ld(&bar[XB_XCNT(j)]); sum += c; cnt += (c > 0u) ? 1u : 0u; mine = (j == x) ? c : mine; }
    if (sum == G) break;
    __builtin_amdgcn_s_sleep(1);
    if ((++sp & 255u) == 0u) { if (xb_ld(&bar[XB_TMO])) break; if (sp > XB_SPIN_CAP) { atomicAdd(&bar[XB_TMO], 1u); break; } }
  }
  nloc = mine > 0u ? mine : 1u; nx = cnt > 0u ? cnt : 1u;
}
DI void xcd_barrier(const XcdBarrier& b) {
  asm volatile("s_waitcnt vmcnt(0)" ::: "memory");
  __syncthreads();
  if (threadIdx.x == 0) {
    unsigned* bar = b.bar;
    __builtin_amdgcn_s_waitcnt(0);
    unsigned nloc = b.st[0], nx = b.st[1];
    if (nloc == 0u) { xcd_barrier_complete(bar, b.x, nloc, nx); b.st[0] = nloc; b.st[1] = nx; }
    const unsigned old = xb_add(&bar[XB_XSUB(b.x)], 1u);
    const unsigned gen = old / nloc;
    if (old + 1u == (gen + 1u) * nloc) {
      __builtin_amdgcn_fence(__ATOMIC_RELEASE, "agent");
      asm volatile("s_waitcnt vmcnt(0)" ::: "memory");
      const unsigned og = xb_add(&bar[XB_TOP], 1u);
      const unsigned tg = og / nx;
      if (og + 1u == (tg + 1u) * nx) xb_add(&bar[XB_TOPGEN], 1u);
      else XB_SPIN(xb_ld(&bar[XB_TOPGEN]) == tg, bar);
      __builtin_amdgcn_fence(__ATOMIC_ACQUIRE, "agent");
      xb_add(&bar[XB_XGEN(b.x)], 1u);
      asm volatile("s_waitcnt vmcnt(0)" ::: "memory");
    } else {
      XB_SPIN(xb_ld(&bar[XB_XGEN(b.x)]) == gen, bar);
      __builtin_amdgcn_fence(__ATOMIC_ACQUIRE, "agent");
      asm volatile("s_waitcnt vmcnt(0)" ::: "memory");
    }
  }
  __syncthreads();
}

DI float wsrc(const float* src, int ld, int mode, const float* aux, int k, int n) {
  if (mode == 0) return gld<float>(src + (size_t)k * ld + n);
  if (mode == 1) { int c = ((n >> 7) & 1) * 1024 + (n >> 8) * 128 + (n & 127); return gld<float>(src + (size_t)k * ld + c); }
  if (n < 2048) return gld<float>(src + (size_t)k * ld + n);
  if (n < 2080) { int j = n - 2048; return gld<float>(aux + ((size_t)(j >> 4) * 1024 + k) * 16 + (j & 15)); }
  return 0.f;
}
DI void wconv_job(const float* src, int ld, int K, int Nd, bf16_t* dst, int mode, const float* aux, float* tile, const float* gain) {
  const int tk = K >> 6, tn = Nd >> 6, nt = tk * tn, tid = otid();
  for (int t = blockIdx.x; t < nt; t += gridDim.x) {
    const int k0 = (t % tk) << 6, n0 = (t / tk) << 6;
    __syncthreads();
    if (mode == 0) {
#pragma unroll
      for (int i = 0; i < 2; ++i) {
        const int kk = (tid >> 4) + 32 * i, n4 = (tid & 15) * 4;
        f32x4 v = gld<f32x4>(src + (size_t)(k0 + kk) * ld + n0 + n4);
        if (gain) v = v * gld<float>(gain + k0 + kk);
        tile[kk * 65 + n4] = v[0]; tile[kk * 65 + n4 + 1] = v[1]; tile[kk * 65 + n4 + 2] = v[2]; tile[kk * 65 + n4 + 3] = v[3];
      }
    } else {
#pragma unroll
      for (int i = 0; i < 8; ++i) { int kk = (tid >> 6) + 8 * i, nn = tid & 63; tile[kk * 65 + nn] = wsrc(src, ld, mode, aux, k0 + kk, n0 + nn) * (gain ? gld<float>(gain + k0 + kk) : 1.0f); }
    }
    __syncthreads();
    const int nn = tid >> 3, k8 = (tid & 7) * 8;
    u32x4 w;
    w.x = pk(tile[(k8 + 0) * 65 + nn], tile[(k8 + 1) * 65 + nn]); w.y = pk(tile[(k8 + 2) * 65 + nn], tile[(k8 + 3) * 65 + nn]);
    w.z = pk(tile[(k8 + 4) * 65 + nn], tile[(k8 + 5) * 65 + nn]); w.w = pk(tile[(k8 + 6) * 65 + nn], tile[(k8 + 7) * 65 + nn]);
    gst<u32x4>(dst + (size_t)(n0 + nn) * K + k0 + k8, w);
  }
}
constexpr size_t W_IN = 0;
constexpr size_t W_G = 4096u * 1024u;
constexpr size_t W_OUT = 6144u * 1024u;
constexpr size_t W_UP = 8192u * 1024u;
constexpr size_t W_DN = 12288u * 1024u;
DI void wconv_layer(int layer, float* tile) {
  bf16_t* W = (bf16_t*)(KP(ws) + OFF_W);
  const int kind = layer % 3, j = layer / 3;
  const float* g0 = KP(norm_gains) + layer * 4096;
  const float* g2 = g0 + 2048;
  if (kind == 0) {
    const float* win = KP(ret_w_in) + (size_t)j * 1024 * 6144;
    wconv_job(win, 6144, 1024, 4096, W + W_IN, 0, nullptr, tile, g0);
    wconv_job(win + 4096, 6144, 1024, 2048, W + W_G, 0, nullptr, tile, g0);
    wconv_job(KP(ret_w_out) + (size_t)j * 2048 * 1024, 1024, 2048, 1024, W + W_OUT, 0, nullptr, tile, nullptr);
  } else if (kind == 1) {
    wconv_job(KP(conv_w_in), 2048, 1024, 2048, W + W_IN, 1, nullptr, tile, g0);
    wconv_job(KP(conv_w_out), 1024, 1024, 1024, W + W_OUT, 0, nullptr, tile, nullptr);
  } else {
    wconv_job(KP(gla_w_in), 3072, 1024, 2304, W + W_IN, 2, KP(gla_w1), tile, g0);
    wconv_job(KP(gla_w_in) + 2048, 3072, 1024, 1024, W + W_G, 0, nullptr, tile, g0);
    wconv_job(KP(gla_w_out), 1024, 1024, 1024, W + W_OUT, 0, nullptr, tile, nullptr);
  }
  wconv_job(KP(mlp_up) + (size_t)layer * 1024 * 4096, 4096, 1024, 4096, W + W_UP, 0, nullptr, tile, g2);
  wconv_job(KP(mlp_down) + (size_t)layer * 4096 * 1024, 1024, 4096, 1024, W + W_DN, 0, nullptr, tile, nullptr);
}

DI void rw_phase(const float* x, bf16_t* hb, const bf16_t* y, const float* gpost, float* rh, float* fout, bool y_unscaled) {
  const int tid_ = otid(), wid = tid_ >> 6, lane = tid_ & 63;
  for (int row = blockIdx.x * 8 + wid; row < T_; row += gridDim.x * 8) {
    float hv[16];
    if (x) {
      const float* hp = x + (size_t)row * 1024;
#pragma unroll
      for (int c = 0; c < 2; ++c) {
        const f32x4 a = gld<f32x4>(hp + 512 * c + 8 * lane), b = gld<f32x4>(hp + 512 * c + 8 * lane + 4);
        hv[8 * c + 0] = a[0]; hv[8 * c + 1] = a[1]; hv[8 * c + 2] = a[2]; hv[8 * c + 3] = a[3];
        hv[8 * c + 4] = b[0]; hv[8 * c + 5] = b[1]; hv[8 * c + 6] = b[2]; hv[8 * c + 7] = b[3];
      }
    } else {
#pragma unroll
      for (int c = 0; c < 2; ++c) {
        const u32x4 w = gld<u32x4>(hb + (size_t)row * 1024 + 512 * c + 8 * lane);
        hv[8 * c + 0] = bflo(w.x); hv[8 * c + 1] = bfhi(w.x); hv[8 * c + 2] = bflo(w.y); hv[8 * c + 3] = bfhi(w.y);
        hv[8 * c + 4] = bflo(w.z); hv[8 * c + 5] = bfhi(w.z); hv[8 * c + 6] = bflo(w.w); hv[8 * c + 7] = bfhi(w.w);
      }
    }
    if (y) {
      float yv[16]; float ss = 0.f;
#pragma unroll
      for (int c = 0; c < 2; ++c) {
        const u32x4 w = gld<u32x4>(y + (size_t)row * 1024 + 512 * c + 8 * lane);
        yv[8 * c + 0] = bflo(w.x); yv[8 * c + 1] = bfhi(w.x); yv[8 * c + 2] = bflo(w.y); yv[8 * c + 3] = bfhi(w.y);
        yv[8 * c + 4] = bflo(w.z); yv[8 * c + 5] = bfhi(w.z); yv[8 * c + 6] = bflo(w.w); yv[8 * c + 7] = bfhi(w.w);
      }
#pragma unroll
      for (int i = 0; i < 16; ++i) ss += yv[i] * yv[i];
      ss = wave_sum(ss);
      float epsn = EPS;
      if (y_unscaled) { const float r = gld<float>(rh + row), r2 = r * r; epsn = EPS / (r2 * r2); }
      const float ry = rsqrtf(ss * (1.0f / 1024.0f) + epsn);
#pragma unroll
      for (int c = 0; c < 2; ++c) {
        const f32x4 g0 = gld<f32x4>(gpost + 512 * c + 8 * lane), g1 = gld<f32x4>(gpost + 512 * c + 8 * lane + 4);
#pragma unroll
        for (int i = 0; i < 4; ++i) { hv[8 * c + i] += yv[8 * c + i] * ry * g0[i]; hv[8 * c + 4 + i] += yv[8 * c + 4 + i] * ry * g1[i]; }
      }
    }
    if (fout) {
      float* op = fout + (size_t)row * 1024;
#pragma unroll
      for (int c = 0; c < 2; ++c) {
        gst<f32x4>(op + 512 * c + 8 * lane, (f32x4){hv[8 * c], hv[8 * c + 1], hv[8 * c + 2], hv[8 * c + 3]});
        gst<f32x4>(op + 512 * c + 8 * lane + 4, (f32x4){hv[8 * c + 4], hv[8 * c + 5], hv[8 * c + 6], hv[8 * c + 7]});
      }
    } else {
      float s2 = 0.f;
#pragma unroll
      for (int c = 0; c < 2; ++c) {
        u32x4 w;
        w.x = pk(hv[8 * c + 0], hv[8 * c + 1]); w.y = pk(hv[8 * c + 2], hv[8 * c + 3]); w.z = pk(hv[8 * c + 4], hv[8 * c + 5]); w.w = pk(hv[8 * c + 6], hv[8 * c + 7]);
        gst<u32x4>(hb + (size_t)row * 1024 + 512 * c + 8 * lane, w);
        s2 += bflo(w.x) * bflo(w.x) + bfhi(w.x) * bfhi(w.x) + bflo(w.y) * bflo(w.y) + bfhi(w.y) * bfhi(w.y) +
              bflo(w.z) * bflo(w.z) + bfhi(w.z) * bfhi(w.z) + bflo(w.w) * bflo(w.w) + bfhi(w.w) * bfhi(w.w);
      }
      s2 = wave_sum(s2);
      if (lane == 0) gst<float>(rh + row, rsqrtf(s2 * (1.0f / 1024.0f) + EPS));
    }
  }
}

DI void stats_phase(const bf16_t* o, int HW, float* rs) {
  const int tid_ = otid(), wid = tid_ >> 6, lane = tid_ & 63;
  for (int row = blockIdx.x * 8 + wid; row < T_; row += gridDim.x * 8) {
    if (HW == 2048) {
#pragma unroll
      for (int c = 0; c < 4; ++c) {
        u32x4 w = gld<u32x4>(o + (size_t)row * 2048 + 512 * c + 8 * lane);
        float s = bflo(w.x) * bflo(w.x) + bfhi(w.x) * bfhi(w.x) + bflo(w.y) * bflo(w.y) + bfhi(w.y) * bfhi(w.y) +
                  bflo(w.z) * bflo(w.z) + bfhi(w.z) * bfhi(w.z) + bflo(w.w) * bflo(w.w) + bfhi(w.w) * bfhi(w.w);
        s = wave_sum(s);
        if (lane == 0) gst<float>(rs + row * 4 + c, rsqrtf(s * (1.0f / 512.0f) + EPS));
      }
    } else {
#pragma unroll
      for (int c = 0; c < 2; ++c) {
        u32x4 w = gld<u32x4>(o + (size_t)row * 1024 + 512 * c + 8 * lane);
        float s = bflo(w.x) * bflo(w.x) + bfhi(w.x) * bfhi(w.x) + bflo(w.y) * bflo(w.y) + bfhi(w.y) * bfhi(w.y) +
                  bflo(w.z) * bflo(w.z) + bfhi(w.z) * bfhi(w.z) + bflo(w.w) * bflo(w.w) + bfhi(w.w) * bfhi(w.w);
#pragma unroll
        for (int of = 1; of < 32; of <<= 1) s += __shfl_xor(s, of);
        if ((lane & 31) == 0) gst<float>(rs + row * 4 + 2 * c + (lane >> 5), rsqrtf(s * (1.0f / 256.0f) + EPS));
      }
    }
  }
}

constexpr int BM = 256, BK = 64, HALF = 128, NXCD = 8, WGM = 8, HT = HALF * BK;
enum { EPI_PLAIN = 0, EPI_RELU2 = 1, EPI_RETQKV = 2, EPI_GATE = 3, EPI_GLU = 4, EPI_GLA = 5 };
struct GemmDesc {
  const bf16_t* A; const bf16_t* Bt; int N; int K; int epi; int dvshift;
  bf16_t* o0; bf16_t* o1; float* f0; const float* bias; const float* c0; const int* pos; const float* rowscale;
};
DI int lds_byte(int r, int c) { int st = (r >> 4) * 2 + (c >> 5), rr = r & 15, cc = c & 31, ob = rr * 64 + cc * 2; return st * 1024 + (ob ^ (((ob >> 9) & 1) << 5)); }
DI void stage_rc(int b, int& R, int& C) { int st = b / 1024, sb = b % 1024, swz = sb ^ (((sb >> 9) & 1) << 5); R = (st >> 1) * 16 + swz / 64; C = (st & 1) * 32 + (swz % 64) / 2; }

DI void gemm_epilogue(const GemmDesc& g, f32x4 (&acc)[2][2][4][2], int brow, int bcol, int wr, int wc, int fr, int fq) {
  const int epi = g.epi;
  const int rowb = brow + wr * 64 + fr, colb = bcol + wc * 32 + 8 * fq;
  if (epi == EPI_PLAIN || epi == EPI_RELU2) {
    const int N = g.N;
#pragma unroll
    for (int bj = 0; bj < 2; ++bj) {
      const int col = colb + bj * HALF;
      f32x4 b0 = {0.f, 0.f, 0.f, 0.f}, b1 = b0;
      if (g.bias) { b0 = gld<f32x4>(g.bias + col); b1 = gld<f32x4>(g.bias + col + 4); }
#pragma unroll
      for (int ai = 0; ai < 2; ++ai)
#pragma unroll
        for (int m = 0; m < 4; ++m) {
          const int row = rowb + ai * HALF + m * 16;
          f32x4 v0 = acc[ai][bj][m][0], v1 = acc[ai][bj][m][1];
          if (g.rowscale) { const float ru = gld<float>(g.rowscale + row); v0 = v0 * ru; v1 = v1 * ru; }
          v0 = v0 + b0; v1 = v1 + b1;
          if (epi == EPI_RELU2) {
#pragma unroll
            for (int j = 0; j < 4; ++j) { float r0 = fmaxf(v0[j], 0.f), r1 = fmaxf(v1[j], 0.f); v0[j] = r0 * r0; v1[j] = r1 * r1; }
          }
          u32x4 w; w.x = pk(v0[0], v0[1]); w.y = pk(v0[2], v0[3]); w.z = pk(v1[0], v1[1]); w.w = pk(v1[2], v1[3]);
          gst<u32x4>(g.o0 + (size_t)row * N + col, w);
        }
    }
  } else if (epi == EPI_RETQKV) {
    if (bcol < 2048) {
      const float sc = (bcol < 1024) ? 0.0625f : 1.0f;
      const int d0 = wc * 32 + 8 * fq;
      float fr_[8];
#pragma unroll
      for (int j = 0; j < 8; ++j) fr_[j] = exp2f(-(float)(d0 + j) * (13.287712379549449f / 128.0f)) * 0.15915494309189535f;
#pragma unroll
      for (int ai = 0; ai < 2; ++ai)
#pragma unroll
        for (int m = 0; m < 4; ++m) {
          const int row = rowb + ai * HALF + m * 16;
          const float pf = (float)gld<int>(g.pos + row);
          const float scr = sc * gld<float>(g.rowscale + row);
          float y1[8], y2[8];
#pragma unroll
          for (int n = 0; n < 2; ++n) {
            const f32x4 x1 = acc[ai][0][m][n], x2 = acc[ai][1][m][n];
#pragma unroll
            for (int j = 0; j < 4; ++j) {
              float rev = pf * fr_[4 * n + j]; rev = rev - rintf(rev);
              const float sn = __builtin_amdgcn_sinf(rev), cs = __builtin_amdgcn_cosf(rev);
              y1[4 * n + j] = (x1[j] * cs - x2[j] * sn) * scr; y2[4 * n + j] = (x2[j] * cs + x1[j] * sn) * scr;
            }
          }
          u32x4 w1, w2;
          w1.x = pk(y1[0], y1[1]); w1.y = pk(y1[2], y1[3]); w1.z = pk(y1[4], y1[5]); w1.w = pk(y1[6], y1[7]);
          w2.x = pk(y2[0], y2[1]); w2.y = pk(y2[2], y2[3]); w2.z = pk(y2[4], y2[5]); w2.w = pk(y2[6], y2[7]);
          bf16_t* op = g.o0 + (size_t)row * 2048 + bcol + d0;
          gst<u32x4>(op, w1); gst<u32x4>(op + 128, w2);
        }
    } else {
#pragma unroll
      for (int bj = 0; bj < 2; ++bj) {
        const int col = colb - 2048 + bj * HALF;
#pragma unroll
        for (int ai = 0; ai < 2; ++ai)
#pragma unroll
          for (int m = 0; m < 4; ++m) {
            const int row = rowb + ai * HALF + m * 16;
            const float ru = gld<float>(g.rowscale + row);
            const f32x4 v0 = acc[ai][bj][m][0] * ru, v1 = acc[ai][bj][m][1] * ru;
            u32x4 w; w.x = pk(v0[0], v0[1]); w.y = pk(v0[2], v0[3]); w.z = pk(v1[0], v1[1]); w.w = pk(v1[2], v1[3]);
            gst<u32x4>(g.o1 + (size_t)row * 2048 + col, w);
          }
      }
    }
  } else if (epi == EPI_GATE) {
    const int N = g.N, dvm = (1 << g.dvshift) - 1;
#pragma unroll
    for (int bj = 0; bj < 2; ++bj) {
      const int col = colb + bj * HALF;
      f32x4 g0 = {1.f, 1.f, 1.f, 1.f}, g1 = g0;
      if (g.c0) { g0 = gld<f32x4>(g.c0 + (col & dvm)); g1 = gld<f32x4>(g.c0 + (col & dvm) + 4); }
      const int head = col >> g.dvshift;
#pragma unroll
      for (int ai = 0; ai < 2; ++ai)
#pragma unroll
        for (int m = 0; m < 4; ++m) {
          const int row = rowb + ai * HALF + m * 16;
          float rs;
          { const float* sp = g.f0 + (size_t)row * 32 + head * 8;
            const f32x4 s0 = gld<f32x4>(sp); float ssum = (s0[0] + s0[1]) + (s0[2] + s0[3]);
            if (g.dvshift == 9) { const f32x4 s1 = gld<f32x4>(sp + 4); ssum += (s1[0] + s1[1]) + (s1[2] + s1[3]); }
            rs = rsqrtf(ssum * (g.dvshift == 9 ? (1.0f / 512.0f) : (1.0f / 256.0f)) + EPS); }
          bf16_t* op = g.o0 + (size_t)row * N + col;
          const u32x4 ow = gld<u32x4>(op);
          const float ru = gld<float>(g.rowscale + row);
          const f32x4 v0 = acc[ai][bj][m][0] * ru, v1 = acc[ai][bj][m][1] * ru;
          float o[8] = {bflo(ow.x), bfhi(ow.x), bflo(ow.y), bfhi(ow.y), bflo(ow.z), bfhi(ow.z), bflo(ow.w), bfhi(ow.w)};
#pragma unroll
          for (int j = 0; j < 4; ++j) { o[j] = o[j] * rs * g0[j] * v0[j] * sigmoidf_(v0[j]); o[4 + j] = o[4 + j] * rs * g1[j] * v1[j] * sigmoidf_(v1[j]); }
          u32x4 w; w.x = pk(o[0], o[1]); w.y = pk(o[2], o[3]); w.z = pk(o[4], o[5]); w.w = pk(o[6], o[7]);
          gst<u32x4>(op, w);
        }
    }
  } else if (epi == EPI_GLU) {
    const int ca = 128 * (bcol >> 8) + wc * 32 + 8 * fq;
    const f32x4 ba0 = gld<f32x4>(g.bias + ca), ba1 = gld<f32x4>(g.bias + ca + 4);
    const f32x4 bg0 = gld<f32x4>(g.bias + 1024 + ca), bg1 = gld<f32x4>(g.bias + 1024 + ca + 4);
#pragma unroll
    for (int ai = 0; ai < 2; ++ai)
#pragma unroll
      for (int m = 0; m < 4; ++m) {
        const int row = rowb + ai * HALF + m * 16;
        const float ru = gld<float>(g.rowscale + row);
        const f32x4 a0 = acc[ai][0][m][0] * ru + ba0, a1 = acc[ai][0][m][1] * ru + ba1, t0 = acc[ai][1][m][0] * ru + bg0, t1 = acc[ai][1][m][1] * ru + bg1;
        float o[8];
#pragma unroll
        for (int j = 0; j < 4; ++j) { o[j] = a0[j] * sigmoidf_(t0[j]); o[4 + j] = a1[j] * sigmoidf_(t1[j]); }
        u32x4 w; w.x = pk(o[0], o[1]); w.y = pk(o[2], o[3]); w.z = pk(o[4], o[5]); w.w = pk(o[6], o[7]);
        gst<u32x4>(g.o0 + (size_t)row * 1024 + ca, w);
      }
  } else {
#pragma unroll
    for (int bj = 0; bj < 2; ++bj) {
      const int col = colb + bj * HALF;
#pragma unroll
      for (int ai = 0; ai < 2; ++ai)
#pragma unroll
        for (int m = 0; m < 4; ++m) {
          const int row = rowb + ai * HALF + m * 16;
          const float ru = gld<float>(g.rowscale + row);
          f32x4 v0 = acc[ai][bj][m][0] * ru, v1 = acc[ai][bj][m][1] * ru;
          if (bcol < 2048) {
            if (bcol < 512) { v0 = v0 * 0.08838834764831845f; v1 = v1 * 0.08838834764831845f; }
            bf16_t* base = (bcol < 1024) ? (g.o0 + (size_t)row * 1024 + col) : (g.o1 + (size_t)row * 1024 + (col - 1024));
            u32x4 w; w.x = pk(v0[0], v0[1]); w.y = pk(v0[2], v0[3]); w.z = pk(v1[0], v1[1]); w.w = pk(v1[2], v1[3]);
            gst<u32x4>(base, w);
          } else if (col < 2080) {
            gst<f32x4>(g.f0 + (size_t)row * 32 + (col - 2048), v0); gst<f32x4>(g.f0 + (size_t)row * 32 + (col - 2048) + 4, v1);
          }
        }
    }
  }
}

DI int perm32(int rho) { const int n = rho >> 4, i = rho & 15; return 8 * (i >> 2) + 4 * n + (i & 3); }
DI bool tile_next(int i, int G, int c, int nM, int nN, int& pm, int& pn) {
  const int nwg = nM * nN; const long L = (long)i * G + c; if (L >= nwg) return false;
  int wgid = (int)L; { const int q = nwg / NXCD, r = nwg % NXCD, xcd = wgid % NXCD, off = wgid / NXCD; wgid = (xcd < r ? xcd * (q + 1) : r * (q + 1) + (xcd - r) * q) + off; }
  const int nig = WGM * nN, gid = wgid / nig, fm = gid * WGM, gsz = (nM - fm) < WGM ? (nM - fm) : WGM;
  pm = fm + ((wgid % nig) % gsz); pn = (wgid % nig) / gsz; return true;
}
DI void gemm_phase(const GemmDesc& g, LAS unsigned char* lds) {
  constexpr int HTB = HALF * BK * 2;
  const int tid = otid(), wid = __builtin_amdgcn_readfirstlane(tid >> 6), lane = tid & 63, wr = wid >> 2, wc = wid & 3, fr = lane & 15, fq = lane >> 4;
  const int K = g.K, nt = K / BK, nM = T_ / BM, nN = g.N / BM, G = gridDim.x, cb = blockIdx.x;
  unsigned voffA[2], voffB[2];
#pragma unroll
  for (int i = 0; i < 2; ++i) { int R, C; stage_rc(tid * 16 + i * 8192, R, C); const int Rb = (R & ~31) + perm32(R & 31);
    voffA[i] = (unsigned)(R * K + C) * 2u; voffB[i] = (unsigned)(Rb * K + C) * 2u; }
  const size_t kstep = (size_t)(BK * 2), hstep = (size_t)HALF * K * 2, tstep = 2 * hstep;
  const unsigned ldsw = (unsigned)wid * 1024u;
  const int aoff = lds_byte(wr * 64 + fr, fq * 8), boff = lds_byte(wc * 32 + fr, fq * 8);
#define PG8_SA(b, h) (((b) * 2 + (h)) * HTB)
#define PG8_SB(b, h) ((4 + (b) * 2 + (h)) * HTB)
#define PG8_STAGE(bufoff, gbase, voff) do { _Pragma("unroll") for (int _i = 0; _i < 2; ++_i) \
    __builtin_amdgcn_global_load_lds((const unsigned*)((const char*)(gbase) + (voff)[_i]), (LAS unsigned*)(lds + (bufoff) + ldsw + _i * 8192), 16, 0, 0); } while (0)
#define PG8_LDA(dst, b, h) do { _Pragma("unroll") for (int m = 0; m < 4; ++m) _Pragma("unroll") for (int k = 0; k < 2; ++k) dst[m][k] = *(const LAS bf16x8*)(lds + PG8_SA(b, h) + aoff + m * 2048 + k * 1024); } while (0)
#define PG8_LDB(dst, b, h) do { _Pragma("unroll") for (int n = 0; n < 2; ++n) _Pragma("unroll") for (int k = 0; k < 2; ++k) dst[n][k] = *(const LAS bf16x8*)(lds + PG8_SB(b, h) + boff + n * 2048 + k * 1024); } while (0)
#define PG8_MMA(ai, bj, At, Bt) do { __builtin_amdgcn_s_setprio(1); _Pragma("unroll") for (int m = 0; m < 4; ++m) _Pragma("unroll") for (int n = 0; n < 2; ++n) _Pragma("unroll") for (int k = 0; k < 2; ++k) \
    acc[ai][bj][m][n] = __builtin_amdgcn_mfma_f32_16x16x32_bf16(Bt[n][k], At[m][k], acc[ai][bj][m][n], 0, 0, 0); __builtin_amdgcn_s_setprio(0); } while (0)
#define PG8_WAIT_V(n) asm volatile("s_waitcnt vmcnt(" #n ")" ::: "memory")
#define PG8_WAIT_L(n) asm volatile("s_waitcnt lgkmcnt(" #n ")" ::: "memory")
#define PG8_BAR __builtin_amdgcn_s_barrier()
#define PG8_SCHED __builtin_amdgcn_sched_barrier(0)
  int cpm, cpn, npm = 0, npn = 0, ui = 0;
  if (!tile_next(0, G, cb, nM, nN, cpm, cpn)) return;
  f32x4 acc[2][2][4][2];
#pragma unroll
  for (int a = 0; a < 2; ++a)
#pragma unroll
    for (int b = 0; b < 2; ++b)
#pragma unroll
      for (int m = 0; m < 4; ++m)
#pragma unroll
        for (int n = 0; n < 2; ++n) acc[a][b][m][n] = (f32x4){0.f, 0.f, 0.f, 0.f};
  bf16x8 At[4][2], B0[2][2], B1[2][2];
  const char* cA = (const char*)g.A + (size_t)cpm * tstep; const char* cB = (const char*)g.Bt + (size_t)cpn * tstep;
  PG8_STAGE(PG8_SB(0, 0), cB, voffB); PG8_STAGE(PG8_SB(0, 1), cB + hstep, voffB); PG8_STAGE(PG8_SA(0, 0), cA, voffA); PG8_STAGE(PG8_SA(0, 1), cA + hstep, voffA);
  if (wr == 1) PG8_BAR;
  PG8_WAIT_V(2); PG8_BAR;
  PG8_STAGE(PG8_SB(1, 0), cB + kstep, voffB); PG8_STAGE(PG8_SA(1, 0), cA + kstep, voffA); PG8_STAGE(PG8_SB(1, 1), cB + hstep + kstep, voffB);
  PG8_WAIT_V(6); PG8_BAR;
  for (;;) {
    const bool has_next = tile_next(ui + 1, G, cb, nM, nN, npm, npn);
    const char* nA = has_next ? (const char*)g.A + (size_t)npm * tstep : cA; const char* nB = has_next ? (const char*)g.Bt + (size_t)npn * tstep : cB;
    for (int t = 0; t < nt; t += 2) {
      const bool last = (t == nt - 2);
      const char* a1 = cA + (size_t)(t + 1) * kstep;
      const char* a2 = last ? nA : cA + (size_t)(t + 2) * kstep; const char* b2 = last ? nB : cB + (size_t)(t + 2) * kstep;
      const char* a3 = a2 + kstep; const char* b3 = b2 + kstep;
      PG8_LDB(B0, 0, 0); PG8_LDB(B1, 0, 1); PG8_SCHED; PG8_LDA(At, 0, 0); PG8_STAGE(PG8_SA(1, 1), a1 + hstep, voffA);
      PG8_WAIT_V(8); PG8_WAIT_L(0); PG8_BAR; PG8_MMA(0, 0, At, B0); PG8_MMA(0, 1, At, B1); PG8_BAR; PG8_SCHED;
      PG8_LDA(At, 0, 1); PG8_STAGE(PG8_SB(0, 0), b2, voffB); PG8_STAGE(PG8_SB(0, 1), b2 + hstep, voffB); PG8_STAGE(PG8_SA(0, 0), a2, voffA);
      PG8_WAIT_V(8); PG8_WAIT_L(0); PG8_BAR; PG8_MMA(1, 0, At, B0); PG8_MMA(1, 1, At, B1); PG8_BAR; PG8_SCHED;
      PG8_LDB(B0, 1, 0); PG8_LDB(B1, 1, 1); PG8_SCHED; PG8_LDA(At, 1, 0); PG8_STAGE(PG8_SA(0, 1), a2 + hstep, voffA);
      PG8_WAIT_V(8); PG8_WAIT_L(0); PG8_BAR; PG8_MMA(0, 0, At, B0); PG8_MMA(0, 1, At, B1); PG8_BAR; PG8_SCHED;
      PG8_LDA(At, 1, 1); PG8_STAGE(PG8_SB(1, 0), b3, voffB); PG8_STAGE(PG8_SB(1, 1), b3 + hstep, voffB); PG8_STAGE(PG8_SA(1, 0), a3, voffA);
      PG8_WAIT_V(8); PG8_WAIT_L(0); PG8_BAR; PG8_MMA(1, 0, At, B0); PG8_MMA(1, 1, At, B1); PG8_BAR; PG8_SCHED;
    }
    if (wr == 0) PG8_BAR;
    gemm_epilogue(g, acc, cpm * BM, cpn * BM, wr, wc, fr, fq);
    if (!has_next) break;
#pragma unroll
    for (int a = 0; a < 2; ++a)
#pragma unroll
      for (int b = 0; b < 2; ++b)
#pragma unroll
        for (int m = 0; m < 4; ++m)
#pragma unroll
          for (int n = 0; n < 2; ++n) acc[a][b][m][n] = (f32x4){0.f, 0.f, 0.f, 0.f};
    cpm = npm; cpn = npn; cA = nA; cB = nB; ++ui;
    if (wr == 1) PG8_BAR;
  }
  PG8_WAIT_V(0);
  PG8_BAR;
}

template <int R> DI void conv_row(f32x2 (&acc)[32], const f32x2 (&wt)[31], const unsigned* tile, int tid) {
  const unsigned x = tile[R * 512 + tid];
  const f32x2 xv = {bflo(x), bfhi(x)};
#pragma unroll
  for (int i = 0; i < 32; ++i) { if (R - i >= 0 && R - i < 31) acc[i] = acc[i] + xv * wt[(R - i >= 0 && R - i < 31) ? R - i : 0]; }
  if ((R & 7) == 7) asm volatile("" ::: "memory");
}
template <int R0, int N> struct ConvRows {
  static DI void run(f32x2 (&acc)[32], const f32x2 (&wt)[31], const unsigned* tile, int tid) { conv_row<R0>(acc, wt, tile, tid); ConvRows<R0 + 1, N - 1>::run(acc, wt, tile, tid); }
};
template <int R0> struct ConvRows<R0, 0> { static DI void run(f32x2 (&)[32], const f32x2 (&)[31], const unsigned*, int) {} };
DI void conv_phase(const bf16_t* hc, bf16_t* hn, char* lds) {
  const float* wdw = KP(conv_w_dw);
  const int tid = otid();
  unsigned* tile = (unsigned*)lds;
  float* red = (float*)lds;
  unsigned toff = 131072; asm volatile("" : "+s"(toff));
  float* tot = (float*)(lds + toff);
  const f32x2 bdw = gld<f32x2>(KP(conv_b_dw) + 2 * tid);
  const f32x2 lg = gld<f32x2>(KP(conv_ln_g) + 2 * tid), lb = gld<f32x2>(KP(conv_ln_b) + 2 * tid);
  for (int item = blockIdx.x; item < T_ / 32; item += gridDim.x) {
    const int b = item >> 8, t0 = (item & 255) * 32;
    __syncthreads();
#pragma unroll
    for (int hf = 0; hf < 2; ++hf) {
      u32x4 w[8];
#pragma unroll
      for (int i = 0; i < 8; ++i) {
        const int c = tid + 512 * (8 * hf + i), r = c >> 7, ch = c & 127, t = t0 - 15 + r;
        w[i] = (u32x4){0u, 0u, 0u, 0u};
        if (r < 62 && t >= 0 && t < L_) w[i] = gld<u32x4>(hc + ((size_t)(b * L_ + t)) * 1024 + ch * 8);
      }
#pragma unroll
      for (int i = 0; i < 8; ++i) {
        const int c = tid + 512 * (8 * hf + i), r = c >> 7, ch = c & 127;
        if (r < 62) *(u32x4*)(tile + r * 512 + ch * 4) = w[i];
      }
      asm volatile("" ::: "memory");
    }
    __syncthreads();
    const float* wd2 = wdw; asm volatile("" : "+s"(wd2));
    f32x2 acc[32], wt[31];
#pragma unroll
    for (int i = 0; i < 32; ++i) acc[i] = bdw;
#pragma unroll
    for (int j = 0; j < 31; ++j) wt[j] = gld<f32x2>(wd2 + j * 1024 + 2 * tid);
    ConvRows<0, 62>::run(acc, wt, tile, tid);
    __syncthreads();
#pragma unroll
    for (int i = 0; i < 32; ++i) { red[i * 512 + tid] = acc[i].x + acc[i].y; red[(32 + i) * 512 + tid] = acc[i].x * acc[i].x + acc[i].y * acc[i].y; }
    __syncthreads();
    {
      const int q = tid >> 3, part = tid & 7;
      float sm = 0.f;
#pragma unroll
      for (int i = 0; i < 16; ++i) { f32x4 v = *(const f32x4*)(red + q * 512 + part * 64 + i * 4); sm += (v[0] + v[1]) + (v[2] + v[3]); }
      sm += __shfl_xor(sm, 1); sm += __shfl_xor(sm, 2); sm += __shfl_xor(sm, 4);
      if (part == 0) tot[q] = sm;
    }
    __syncthreads();
#pragma unroll
    for (int i = 0; i < 32; ++i) {
      const float mu = tot[i] * (1.0f / 1024.0f), var = fmaxf(tot[32 + i] * (1.0f / 1024.0f) - mu * mu, 0.f), rstd = rsqrtf(var + EPS);
      float y0 = (acc[i].x - mu) * rstd * lg.x + lb.x, y1 = (acc[i].y - mu) * rstd * lg.y + lb.y;
      y0 = y0 * sigmoidf_(y0); y1 = y1 * sigmoidf_(y1);
      gst<unsigned>(hn + ((size_t)(b * L_ + t0 + i)) * 1024 + 2 * tid, pk(y0, y1));
    }
  }
}

DI void glaprep_phase(const bf16_t* qk, const float* t1, bf16_t* QKf, bf16_t* QKb, float* E, char* lds) {
  const int tid = otid();
  float* t1s = (float*)lds;
  bf16_t* raw = (bf16_t*)(lds + 8192);
  float w2f[16], w2b[16];
  const float* gw2 = KP(gla_w2); const float* ggb = KP(gla_gb);
#pragma unroll
  for (int r = 0; r < 16; ++r) { w2f[r] = gld<float>(gw2 + r * 512 + tid); w2b[r] = gld<float>(gw2 + (16 + r) * 512 + tid); }
  const float bf_ = gld<float>(ggb + tid), bb_ = gld<float>(ggb + 512 + tid);
  for (int item = blockIdx.x; item < T_ / 64; item += gridDim.x) {
    const size_t tok0 = (size_t)item * 64;
    __syncthreads();
    {
      u32x4 w[16];
#pragma unroll
      for (int i = 0; i < 16; ++i) w[i] = gld<u32x4>(qk + tok0 * 1024 + (size_t)(tid + 512 * i) * 8);
      const f32x4 tv = gld<f32x4>(t1 + tok0 * 32 + tid * 4);
#pragma unroll
      for (int i = 0; i < 16; ++i) *(u32x4*)(raw + (size_t)(tid + 512 * i) * 8) = w[i];
      *(f32x4*)(t1s + tid * 4) = tv;
    }
    __syncthreads();
    float c = 0.f;
#pragma unroll 8
    for (int i = 0; i < 64; ++i) {
      float lgt = bf_;
#pragma unroll
      for (int r = 0; r < 16; ++r) lgt += t1s[i * 32 + r] * w2f[r];
      c += log_sigmoid_(lgt) * (1.0f / 16.0f);
      const float qv = bf1(raw[i * 1024 + tid]), kv = bf1(raw[i * 1024 + 512 + tid]);
      gst<bf16_t>(QKf + (tok0 + i) * 1024 + tid, tobf(qv * __expf(c)));
      gst<bf16_t>(QKf + (tok0 + i) * 1024 + 512 + tid, tobf(kv * __expf(-c)));
    }
    gst<float>(E + (size_t)item * 512 + tid, __expf(c));
    c = 0.f;
#pragma unroll 8
    for (int i = 63; i >= 0; --i) {
      float lgt = bb_;
#pragma unroll
      for (int r = 0; r < 16; ++r) lgt += t1s[i * 32 + 16 + r] * w2b[r];
      c += log_sigmoid_(lgt) * (1.0f / 16.0f);
      const float qv = bf1(raw[i * 1024 + tid]), kv = bf1(raw[i * 1024 + 512 + tid]);
      gst<bf16_t>(QKb + (tok0 + i) * 1024 + tid, tobf(qv * __expf(c)));
      gst<bf16_t>(QKb + (tok0 + i) * 1024 + 512 + tid, tobf(kv * __expf(-c)));
    }
    gst<float>(E + (size_t)(T_ / 64) * 512 + (size_t)item * 512 + tid, __expf(c));
  }
}

template <int DK, bool GLA>
DI void ppass_phase(const bf16_t* Qf, const bf16_t* Kf, const bf16_t* Qb, const bf16_t* Kb, int ld, const float* decay, bf16_t* P) {
  const int tid_ = otid(), wid = tid_ >> 6, lane = tid_ & 63, fr = lane & 15, fq = lane >> 4;
  const int rt = wid >> 1, ct0 = 2 * (wid & 1);
  for (int item = blockIdx.x; item < 2048; item += gridDim.x) {
    const int n = item & 127, h = (item >> 7) & 3, b = item >> 9;
    const size_t tok0 = (size_t)b * L_ + n * 64;
    f32x4 xf[2] = {}, xb[2] = {};
    const bf16_t* qa = Qf + (tok0 + 16 * rt + fr) * ld + h * DK + 8 * fq;
    const bf16_t* ka0 = Kf + (tok0 + 16 * ct0 + fr) * ld + h * DK + 8 * fq;
    const bf16_t* ka1 = ka0 + (size_t)16 * ld;
#pragma unroll
    for (int kk = 0; kk < DK / 32; ++kk) {
      const bf16x8 a = gld<bf16x8>(qa + 32 * kk), b0 = gld<bf16x8>(ka0 + 32 * kk), b1 = gld<bf16x8>(ka1 + 32 * kk);
      xf[0] = __builtin_amdgcn_mfma_f32_16x16x32_bf16(a, b0, xf[0], 0, 0, 0);
      xf[1] = __builtin_amdgcn_mfma_f32_16x16x32_bf16(a, b1, xf[1], 0, 0, 0);
    }
    if (GLA) {
      const bf16_t* qb = Qb + (tok0 + 16 * rt + fr) * ld + h * DK + 8 * fq;
      const bf16_t* kb0 = Kb + (tok0 + 16 * ct0 + fr) * ld + h * DK + 8 * fq;
      const bf16_t* kb1 = kb0 + (size_t)16 * ld;
#pragma unroll
      for (int kk = 0; kk < DK / 32; ++kk) {
        const bf16x8 a = gld<bf16x8>(qb + 32 * kk), b0 = gld<bf16x8>(kb0 + 32 * kk), b1 = gld<bf16x8>(kb1 + 32 * kk);
        xb[0] = __builtin_amdgcn_mfma_f32_16x16x32_bf16(a, b0, xb[0], 0, 0, 0);
        xb[1] = __builtin_amdgcn_mfma_f32_16x16x32_bf16(a, b1, xb[1], 0, 0, 0);
      }
    }
    bf16_t* Po = P + (size_t)item * 4096;
    Po = P + ((size_t)((b * 128 + n) * 4 + h)) * 4096;
#pragma unroll
    for (int c = 0; c < 2; ++c)
#pragma unroll
      for (int j = 0; j < 4; ++j) {
        const int i = 16 * rt + 4 * fq + j, s = 16 * (ct0 + c) + fr;
        float v;
        if (GLA) v = (s <= i) ? xf[c][j] : xb[c][j];
        else v = xf[c][j];
        gst<bf16_t>(Po + i * 64 + s, tobf(v));
      }
  }
}

struct FalseC { static constexpr bool value = false; }; struct TrueC { static constexpr bool value = true; };
struct ScanArgs {
  const bf16_t* q0; const bf16_t* q1; const bf16_t* k0; const bf16_t* k1;
  const bf16_t* v; const bf16_t* P; bf16_t* o;
  const float* E;
  const float* decay;
  float* ssp;
};
DI s16x4 tr_read(unsigned a) { s16x4 r; asm volatile("ds_read_b64_tr_b16 %0, %1\n\ts_waitcnt lgkmcnt(0)" : "=&v"(r) : "v"(a) : "memory"); return r; }
template <int SA_, int SB_>
DI void tr_read8(unsigned a, s16x4 (&r)[8]) {
  asm volatile("ds_read_b64_tr_b16 %0, %8 offset:%9\n\tds_read_b64_tr_b16 %1, %8 offset:%10\n\tds_read_b64_tr_b16 %2, %8 offset:%11\n\tds_read_b64_tr_b16 %3, %8 offset:%12\n\t"
               "ds_read_b64_tr_b16 %4, %8 offset:%13\n\tds_read_b64_tr_b16 %5, %8 offset:%14\n\tds_read_b64_tr_b16 %6, %8 offset:%15\n\tds_read_b64_tr_b16 %7, %8 offset:%16\n\t"
               "s_waitcnt lgkmcnt(0)"
               : "=&v"(r[0]), "=&v"(r[1]), "=&v"(r[2]), "=&v"(r[3]), "=&v"(r[4]), "=&v"(r[5]), "=&v"(r[6]), "=&v"(r[7])
               : "v"(a), "n"(0), "n"(SA_), "n"(SB_), "n"(SB_ + SA_), "n"(2 * SB_), "n"(2 * SB_ + SA_), "n"(3 * SB_), "n"(3 * SB_ + SA_)
               : "memory");
}
template <int SA_, int SB_>
DI void tr_issue8(unsigned a, s16x4 (&r)[8]) {
  asm volatile("ds_read_b64_tr_b16 %0, %8 offset:%9\n\tds_read_b64_tr_b16 %1, %8 offset:%10\n\tds_read_b64_tr_b16 %2, %8 offset:%11\n\tds_read_b64_tr_b16 %3, %8 offset:%12\n\t"
               "ds_read_b64_tr_b16 %4, %8 offset:%13\n\tds_read_b64_tr_b16 %5, %8 offset:%14\n\tds_read_b64_tr_b16 %6, %8 offset:%15\n\tds_read_b64_tr_b16 %7, %8 offset:%16"
               : "=&v"(r[0]), "=&v"(r[1]), "=&v"(r[2]), "=&v"(r[3]), "=&v"(r[4]), "=&v"(r[5]), "=&v"(r[6]), "=&v"(r[7])
               : "v"(a), "n"(0), "n"(SA_), "n"(SB_), "n"(SB_ + SA_), "n"(2 * SB_), "n"(2 * SB_ + SA_), "n"(3 * SB_), "n"(3 * SB_ + SA_)
               : "memory");
}
template <int SA_>
DI void tr_issue2(unsigned a, s16x4 (&r)[2]) {
  asm volatile("ds_read_b64_tr_b16 %0, %2\n\tds_read_b64_tr_b16 %1, %2 offset:%3" : "=&v"(r[0]), "=&v"(r[1]) : "v"(a), "n"(SA_) : "memory");
}
DI void tr_wait10(s16x4 (&a)[8], s16x4 (&b)[2]) {
  asm volatile("s_waitcnt lgkmcnt(0)" : "+v"(a[0]), "+v"(a[1]), "+v"(a[2]), "+v"(a[3]), "+v"(a[4]), "+v"(a[5]), "+v"(a[6]), "+v"(a[7]), "+v"(b[0]), "+v"(b[1]) :: "memory");
}
DI void tr_wait8(s16x4 (&a)[8]) {
  asm volatile("s_waitcnt lgkmcnt(0)" : "+v"(a[0]), "+v"(a[1]), "+v"(a[2]), "+v"(a[3]), "+v"(a[4]), "+v"(a[5]), "+v"(a[6]), "+v"(a[7]) :: "memory");
}
DI void tr_wait16(s16x4 (&a)[8], s16x4 (&b)[8]) {
  asm volatile("s_waitcnt lgkmcnt(0)" : "+v"(a[0]), "+v"(a[1]), "+v"(a[2]), "+v"(a[3]), "+v"(a[4]), "+v"(a[5]), "+v"(a[6]), "+v"(a[7]),
               "+v"(b[0]), "+v"(b[1]), "+v"(b[2]), "+v"(b[3]), "+v"(b[4]), "+v"(b[5]), "+v"(b[6]), "+v"(b[7]) :: "memory");
}
DI bf16x8 cat8(s16x4 a, s16x4 b) { bf16x8 r; r[0] = a[0]; r[1] = a[1]; r[2] = a[2]; r[3] = a[3]; r[4] = b[0]; r[5] = b[1]; r[6] = b[2]; r[7] = b[3]; return r; }
DI u32x4 scale8(u32x4 w, float s) {
  u32x4 r; r.x = pk(bflo(w.x) * s, bfhi(w.x) * s); r.y = pk(bflo(w.y) * s, bfhi(w.y) * s); r.z = pk(bflo(w.z) * s, bfhi(w.z) * s); r.w = pk(bflo(w.w) * s, bfhi(w.w) * s); return r;
}
template <int DK>
DI void scan_phase(const ScanArgs& a, char* lds, const XcdBarrier& xb) {
  constexpr int QS = DK * 2 + 16, KS = DK * 2 + 64, VS = 192, PS = 144, NQ = DK / 128 * 2;
  constexpr int RW = DK / 4, NT = RW / 32;
  constexpr int LDQK = (DK == 256) ? 2048 : 1024, LDV = LDQK, LDO = LDQK, DVH = 2 * DK;
  constexpr bool ret = (DK == 256);
  constexpr int OFF_K = 64 * QS, OFF_V = OFF_K + 64 * KS, OFF_PP = OFF_V + 64 * VS, OFF_O = OFF_PP + 64 * PS, OFF_EE = OFF_O + 65536, OFF_SC = OFF_EE + DK * 4;
  static_assert(OFF_SC + 512 <= (int)LDS_BYTES - 16, "LDS budget");
  const int tid = otid(), wid = tid >> 6, lane = tid & 63, wr = __builtin_amdgcn_readfirstlane(wid >> 1), wc = __builtin_amdgcn_readfirstlane(wid & 1);
  const int r = lane & 31, hh = lane >> 5, g1 = (lane >> 4) & 1, i16 = lane & 15, qd = i16 >> 2, pp = i16 & 3;
  const unsigned ldsb = (unsigned)(uintptr_t)lds;
  float* qsc = (float*)(lds + OFF_SC); float* ksc = qsc + 64;
  constexpr int NS = DVH >> 6, nitems = 32 * NS;
  const int bid = obid(), xcd = bid & 7, inx = bid >> 3;
  const bool g256 = (gridDim.x == 256);
  const bool active = g256 ? (inx < 4 * NS) : (bid < nitems);
  const int item = g256 ? ((xcd * 4 + inx / NS) * NS + inx % NS) : bid;
  const int slice = item % NS, dir = (item / NS) & 1, h = (item / (2 * NS)) & 3, b = item / (8 * NS);
  float econst = 1.f;
  if (active && ret) {
    const float lg = log_sigmoid_(gld<float>(a.decay + dir * 4 + h));
    econst = __expf(64.f * lg);
    if (tid < 64) { const float e = dir ? (float)(64 - tid) : (float)(tid + 1); qsc[tid] = __expf(lg * e); ksc[tid] = __expf(-lg * e); }
  }
  __syncthreads();
  const bf16_t* qg = (dir ? a.q1 : a.q0) + (size_t)b * L_ * LDQK + h * DK;
  const bf16_t* kg = (dir ? a.k1 : a.k0) + (size_t)b * L_ * LDQK + h * DK;
  const bf16_t* vg = a.v + (size_t)b * L_ * LDV + h * DVH + slice * 64;
  bf16_t* og = a.o + (size_t)b * L_ * LDO + h * DVH + slice * 64;
  const bf16_t* pg = a.P + ((size_t)(b * 128) * 4 + h) * 4096;
  const float* eg = ret ? nullptr : (a.E + (size_t)dir * (T_ / 64) * (4 * DK) + (size_t)(b * 128) * (4 * DK) + h * DK);
  f32x16 S[NT];
#pragma unroll
  for (int j = 0; j < NT; ++j)
#pragma unroll
    for (int e = 0; e < 16; ++e) S[j][e] = 0.f;
  struct Regs { u32x4 q[NQ], k[NQ], v, p; };
  Regs RA, RB;
  constexpr int DEPTH = (DK == 128) ? 2 : 1;
  float enext = 1.f;
  const int vrow = tid >> 3, vch = tid & 7;
  auto chunk_of = [&](int st) { const int s2 = st < 128 ? st : 127; return dir ? 127 - s2 : s2; };
  unsigned qoff[NQ];
#pragma unroll
  for (int i = 0; i < NQ; ++i) { const int c = tid + 512 * i, row = c / (DK / 8), ch = c % (DK / 8); qoff[i] = (unsigned)(row * LDQK + ch * 8) * 2u; }
  const unsigned voff = (unsigned)(vrow * LDV + vch * 8) * 2u, poff = (unsigned)(vrow * 64 + vch * 8) * 2u, ooff = (unsigned)(vrow * LDO + vch * 8) * 2u;
  auto issue = [&](Regs& R, int n) {
    const char* qb = (const char*)qg + (size_t)n * (64 * LDQK * 2);
    const char* kb2 = (const char*)kg + (size_t)n * (64 * LDQK * 2);
#pragma unroll
    for (int i = 0; i < NQ; ++i) { R.q[i] = gld<u32x4>(qb + qoff[i]); R.k[i] = gld<u32x4>(kb2 + qoff[i]); }
    R.v = gld<u32x4>((const char*)vg + (size_t)n * (64 * LDV * 2) + voff);
    R.p = gld<u32x4>((const char*)pg + (size_t)n * (4 * 4096 * 2) + poff);
  };
  auto issue1 = [&](int n1) { if (!ret) enext = gld<float>(eg + (size_t)n1 * (4 * DK) + (tid < DK ? tid : 0)); };
  auto step_fn = [&](Regs& R, int step, auto second_c) {
    constexpr bool second = decltype(second_c)::value;
    const int n = dir ? 127 - step : step;
    u32x4 ocur = {0u, 0u, 0u, 0u};
    if (second) ocur = gld<u32x4>((const char*)og + (size_t)n * (64 * LDO * 2) + ooff);
#pragma unroll
    for (int i = 0; i < NQ; ++i) {
      const int c = tid + 512 * i, row = c / (DK / 8), ch = c % (DK / 8);
      *(u32x4*)(lds + row * QS + ch * 16) = R.q[i];
      *(u32x4*)(lds + OFF_K + row * KS + ch * 16) = R.k[i];
    }
    *(u32x4*)(lds + OFF_V + vrow * VS + vch * 16) = ret ? scale8(R.v, ksc[vrow]) : R.v;
    {
      u32x4 w = R.p; unsigned ww[4] = {w.x, w.y, w.z, w.w};
#pragma unroll
      for (int e = 0; e < 4; ++e) {
        const int s0 = vch * 8 + 2 * e, s1 = s0 + 1;
        const bool k0 = dir ? (s0 > vrow) : (s0 <= vrow), k1 = dir ? (s1 > vrow) : (s1 <= vrow);
        ww[e] = (k0 ? (ww[e] & 0xffffu) : 0u) | (k1 ? (ww[e] & 0xffff0000u) : 0u);
      }
      *(u32x4*)(lds + OFF_PP + vrow * PS + vch * 16) = (u32x4){ww[0], ww[1], ww[2], ww[3]};
    }
    if (!ret) { if (tid < DK) *(float*)(lds + OFF_EE + tid * 4) = enext; }
    lds_barrier();
    issue(R, chunk_of(step + DEPTH));
    issue1(chunk_of(step + 1));
    bf16x8 vf[4];
    bf16x8 qa[2][2];
    auto ldq = [&](int jk, bf16x8 (&dst)[2]) {
      const int j = jk >> 1, ks = jk & 1;
#pragma unroll
      for (int tt = 0; tt < 2; ++tt) {
        const char* qp = lds + (32 * tt + r) * QS + (wr * RW + 32 * j + 16 * ks + 4 * hh) * 2;
        dst[tt] = cat8(*(const s16x4*)qp, *(const s16x4*)(qp + 16));
      }
    };
    f32x16 oacc[2];
    const f32x16 zero16 = {0.f, 0.f, 0.f, 0.f, 0.f, 0.f, 0.f, 0.f, 0.f, 0.f, 0.f, 0.f, 0.f, 0.f, 0.f, 0.f};
    {
      s16x4 t8[8];
      tr_issue8<4 * VS, 16 * VS>(ldsb + OFF_V + (8 * hh + qd) * VS + (32 * wc + 16 * g1 + 4 * pp) * 2, t8);
      const bf16x8 pa0 = *(const bf16x8*)(lds + OFF_PP + r * PS + (16 * wr + 8 * hh) * 2);
      const bf16x8 pa1 = *(const bf16x8*)(lds + OFF_PP + (32 + r) * PS + (16 * wr + 8 * hh) * 2);
      s16x4 tv[2];
      tr_issue2<4 * VS>(ldsb + OFF_V + (16 * wr + 8 * hh + qd) * VS + (32 * wc + 16 * g1 + 4 * pp) * 2, tv);
      ldq(0, qa[0]);
      tr_wait10(t8, tv);
#pragma unroll
      for (int s4 = 0; s4 < 4; ++s4) vf[s4] = cat8(t8[2 * s4], t8[2 * s4 + 1]);
      const bf16x8 vpv = cat8(tv[0], tv[1]);
      oacc[0] = __builtin_amdgcn_mfma_f32_32x32x16_bf16(pa0, vpv, zero16, 0, 0, 0);
      oacc[1] = __builtin_amdgcn_mfma_f32_32x32x16_bf16(pa1, vpv, zero16, 0, 0, 0);
    }
#pragma unroll
    for (int jk = 0; jk < 2 * NT; ++jk) {
      if (jk + 1 < 2 * NT) ldq(jk + 1, qa[(jk + 1) & 1]);
      __builtin_amdgcn_sched_barrier(0);
      const int j = jk >> 1, ks = jk & 1;
      u32x4 sb;
      sb.x = pk(S[j][8 * ks + 0], S[j][8 * ks + 1]); sb.y = pk(S[j][8 * ks + 2], S[j][8 * ks + 3]);
      sb.z = pk(S[j][8 * ks + 4], S[j][8 * ks + 5]); sb.w = pk(S[j][8 * ks + 6], S[j][8 * ks + 7]);
      const bf16x8 bfr = __builtin_bit_cast(bf16x8, sb);
      oacc[0] = __builtin_amdgcn_mfma_f32_32x32x16_bf16(qa[jk & 1][0], bfr, oacc[0], 0, 0, 0);
      oacc[1] = __builtin_amdgcn_mfma_f32_32x32x16_bf16(qa[jk & 1][1], bfr, oacc[1], 0, 0, 0);
      __builtin_amdgcn_sched_barrier(0);
    }
#pragma unroll
    for (int tt = 0; tt < 2; ++tt)
#pragma unroll
      for (int e = 0; e < 16; ++e) {
        const int t = 32 * tt + (e & 3) + 8 * (e >> 2) + 4 * hh;
        *(float*)(lds + OFF_O + ((wr * 64 + t) * 64 + 32 * wc + r) * 4) = oacc[tt][e];
      }
    {
      s16x4 ka[8], kb[8];
      tr_issue8<4 * KS, 16 * KS>(ldsb + OFF_K + (8 * hh + qd) * KS + (wr * RW + 16 * g1 + 4 * pp) * 2, ka);
      if (NT == 2) tr_issue8<4 * KS, 16 * KS>(ldsb + OFF_K + (8 * hh + qd) * KS + (wr * RW + 32 + 16 * g1 + 4 * pp) * 2, kb);
      if (NT == 2) tr_wait16(ka, kb); else tr_wait8(ka);
#pragma unroll
      for (int s4 = 0; s4 < 4; ++s4) {
        S[0] = __builtin_amdgcn_mfma_f32_32x32x16_bf16(cat8(ka[2 * s4], ka[2 * s4 + 1]), vf[s4], S[0], 0, 0, 0);
        if (NT == 2) S[NT - 1] = __builtin_amdgcn_mfma_f32_32x32x16_bf16(cat8(kb[2 * s4], kb[2 * s4 + 1]), vf[s4], S[NT - 1], 0, 0, 0);
      }
    }
#pragma unroll
    for (int j = 0; j < NT; ++j) {
      if (ret) {
#pragma unroll
        for (int e = 0; e < 16; ++e) S[j][e] *= econst;
      } else {
#pragma unroll
        for (int gq = 0; gq < 4; ++gq) {
          const f32x4 ev = *(const f32x4*)(lds + OFF_EE + (wr * RW + 32 * j + 8 * gq + 4 * hh) * 4);
#pragma unroll
          for (int e = 0; e < 4; ++e) S[j][4 * gq + e] *= ev[e];
        }
      }
    }
    lds_barrier();
    {
      float sum[8];
#pragma unroll
      for (int e = 0; e < 8; ++e) sum[e] = 0.f;
#pragma unroll
      for (int w4 = 0; w4 < 4; ++w4) {
        const float* op = (const float*)(lds + OFF_O + ((w4 * 64 + vrow) * 64 + vch * 8) * 4);
        const f32x4 x0 = *(const f32x4*)op, x1 = *(const f32x4*)(op + 4);
        sum[0] += x0[0]; sum[1] += x0[1]; sum[2] += x0[2]; sum[3] += x0[3]; sum[4] += x1[0]; sum[5] += x1[1]; sum[6] += x1[2]; sum[7] += x1[3];
      }
      if (ret) {
        const float myqs = qsc[vrow];
#pragma unroll
        for (int e = 0; e < 8; ++e) sum[e] *= myqs;
      }
      if (second) {
        sum[0] += bflo(ocur.x); sum[1] += bfhi(ocur.x); sum[2] += bflo(ocur.y); sum[3] += bfhi(ocur.y);
        sum[4] += bflo(ocur.z); sum[5] += bfhi(ocur.z); sum[6] += bflo(ocur.w); sum[7] += bfhi(ocur.w);
      }
      u32x4 w; w.x = pk(sum[0], sum[1]); w.y = pk(sum[2], sum[3]); w.z = pk(sum[4], sum[5]); w.w = pk(sum[6], sum[7]);
      gst<u32x4>((char*)og + (size_t)n * (64 * LDO * 2) + ooff, w);
      if (second) {
        float q2 = bflo(w.x) * bflo(w.x) + bfhi(w.x) * bfhi(w.x) + bflo(w.y) * bflo(w.y) + bfhi(w.y) * bfhi(w.y) +
                   bflo(w.z) * bflo(w.z) + bfhi(w.z) * bfhi(w.z) + bflo(w.w) * bflo(w.w) + bfhi(w.w) * bfhi(w.w);
        q2 += __shfl_xor(q2, 1); q2 += __shfl_xor(q2, 2); q2 += __shfl_xor(q2, 4);
        if (vch == 0) gst<float>(a.ssp + ((size_t)b * L_ + (size_t)n * 64 + vrow) * 32 + h * 8 + slice, q2);
      }
    }
  };
  if (active) {
    issue(RA, chunk_of(0)); issue1(chunk_of(0));
    if (DEPTH == 2) {
      issue(RB, chunk_of(1));
      for (int step = 0; step < 64; step += 2) { step_fn(RA, step, FalseC{}); step_fn(RB, step + 1, FalseC{}); }
    } else {
      for (int step = 0; step < 64; ++step) step_fn(RA, step, FalseC{});
    }
  }
  xcd_barrier(xb);
  if (active) {
    if (DEPTH == 2) {
      for (int step = 64; step < 128; step += 2) { step_fn(RA, step, TrueC{}); step_fn(RB, step + 1, TrueC{}); }
    } else {
      for (int step = 64; step < 128; ++step) step_fn(RA, step, TrueC{});
    }
  }
}

__global__ void __launch_bounds__(512, 2) mega(Params p) {
  cg::grid_group grid = cg::this_grid();
  extern __shared__ __attribute__((aligned(16))) char lds[];
  char* ws = KP(ws);
  volatile LAS unsigned* xst = (volatile LAS unsigned*)(LAS char*)(lds + (LDS_BYTES - 16));
  if (threadIdx.x == 0) { xst[0] = 0u; xst[1] = 0u; }
  __syncthreads();
  XcdBarrier xb = xcd_barrier_post((unsigned*)(ws + OFF_BAR), xst);
  rw_phase(KP(x), (bf16_t*)(ws + OFF_D), nullptr, nullptr, (float*)(ws + OFF_RS + 512 * 1024), nullptr, false);
  wconv_layer(0, (float*)lds);
  if (gridDim.x == 0x7fffffffu) grid.sync();
  xcd_barrier(xb);

  for (int layer = 0; layer < 4; ++layer) {
    const int kind0 = layer % 3;
    const int nsteps = (kind0 == 0 ? 6 : kind0 == 1 ? 4 : 7) + 3;
    const int nmix = nsteps - 3;
    for (int s = 0; s < nsteps; ++s) {
      int lyr = layer; asm volatile("" : "+s"(lyr));
      const int kind = (lyr == 3) ? 0 : lyr;
      char* ws = KP(ws);
      bf16_t* W = (bf16_t*)(ws + OFF_W);
      bf16_t* bA = (bf16_t*)(ws + OFF_A); bf16_t* bB = (bf16_t*)(ws + OFF_B); bf16_t* bC = (bf16_t*)(ws + OFF_C); bf16_t* bU = (bf16_t*)(ws + OFF_D);
      bf16_t* bP = (bf16_t*)(ws + OFF_P);
      float* rs = (float*)(ws + OFF_RS); float* Eb = (float*)(ws + OFF_E); float* t1 = (float*)(ws + OFF_T1);
      float* rh = (float*)(ws + OFF_RS + 512 * 1024);
      const float* G = KP(norm_gains);
      const float* gl = G + lyr * 4096;
      GemmDesc g{}; bool is_gemm = false;

      const int ms = s - nmix;
      if (ms == 0) { is_gemm = true; g.A = bU; g.Bt = W + W_UP; g.N = 4096; g.K = 1024; g.epi = EPI_RELU2; g.o0 = bA; g.rowscale = nullptr; }
      else if (ms == 1) { is_gemm = true; g.A = bA; g.Bt = W + W_DN; g.N = 1024; g.K = 4096; g.epi = EPI_PLAIN; g.o0 = bC; }
      else if (ms == 2) {
        rw_phase(nullptr, bU, bC, gl + 3072, rh, (lyr < 3) ? nullptr : KP(out), true);
        if (lyr < 3) wconv_layer(lyr + 1, (float*)lds);
      } else if (kind == 0) {
        const float* dec = KP(ret_decay) + (lyr / 3) * 8;
        if (s == 0) { is_gemm = true; g.A = bU; g.Bt = W + W_IN; g.N = 4096; g.K = 1024; g.epi = EPI_RETQKV; g.o0 = bA; g.o1 = bB; g.pos = KP(pos); g.rowscale = rh; }
        else if (s == 1) ppass_phase<256, false>(bA, bA + 1024, nullptr, nullptr, 2048, dec, bP);
        else if (s == 2) {
          ScanArgs a{}; a.q0 = a.q1 = bA; a.k0 = a.k1 = bA + 1024; a.v = bB; a.P = bP; a.o = bC;
          a.E = nullptr; a.decay = dec; a.ssp = t1;
          scan_phase<256>(a, lds, xb);
        }
        else if (s == 3) { is_gemm = true; g.A = bU; g.Bt = W + W_G; g.N = 2048; g.K = 1024; g.epi = EPI_GATE; g.dvshift = 9; g.o0 = bC; g.f0 = t1; g.c0 = nullptr; g.rowscale = rh; }
        else if (s == 4) { is_gemm = true; g.A = bC; g.Bt = W + W_OUT; g.N = 1024; g.K = 2048; g.epi = EPI_PLAIN; g.o0 = bA; }
        else rw_phase(nullptr, bU, bA, gl + 1024, rh, nullptr, false);
      } else if (kind == 1) {
        if (s == 0) { is_gemm = true; g.A = bU; g.Bt = W + W_IN; g.N = 2048; g.K = 1024; g.epi = EPI_GLU; g.o0 = bA; g.bias = KP(conv_b_in); g.rowscale = rh; }
        else if (s == 1) conv_phase(bA, bB, lds);
        else if (s == 2) { is_gemm = true; g.A = bB; g.Bt = W + W_OUT; g.N = 1024; g.K = 1024; g.epi = EPI_PLAIN; g.o0 = bC; g.bias = KP(conv_b_out); }
        else rw_phase(nullptr, bU, bC, gl + 1024, rh, nullptr, false);
      } else {
        bf16_t* gv = bA + (size_t)T_ * 1024; bf16_t* qkb = bB + (size_t)T_ * 1024; bf16_t* gy = bC + (size_t)T_ * 1024;
        if (s == 0) { is_gemm = true; g.A = bU; g.Bt = W + W_IN; g.N = 2304; g.K = 1024; g.epi = EPI_GLA; g.o0 = bA; g.o1 = gv; g.f0 = t1; g.rowscale = rh; }
        else if (s == 1) glaprep_phase(bA, t1, bB, qkb, Eb, lds);
        else if (s == 2) ppass_phase<128, true>(bB, bB + 512, qkb, qkb + 512, 1024, nullptr, bP);
        else if (s == 3) {
          ScanArgs a{}; a.q0 = bB; a.k0 = bB + 512; a.q1 = qkb; a.k1 = qkb + 512; a.v = gv; a.P = bP; a.o = bC;
          a.E = Eb; a.decay = nullptr; a.ssp = t1;
          scan_phase<128>(a, lds, xb);
        }
        else if (s == 4) { is_gemm = true; g.A = bU; g.Bt = W + W_G; g.N = 1024; g.K = 1024; g.epi = EPI_GATE; g.dvshift = 8; g.o0 = bC; g.f0 = t1; g.c0 = KP(gla_ng); g.rowscale = rh; }
        else if (s == 5) { is_gemm = true; g.A = bC; g.Bt = W + W_OUT; g.N = 1024; g.K = 1024; g.epi = EPI_PLAIN; g.o0 = gy; }
        else rw_phase(nullptr, bU, gy, gl + 1024, rh, nullptr, false);
      }
      if (is_gemm) gemm_phase(g, (LAS unsigned char*)lds);
      xcd_barrier(xb);
    }
  }
}

extern "C" void kernel_launch(void* const* d_in, const int* in_sizes, int n_in, void* d_out, int out_size,
                              void* d_ws, size_t ws_size, hipStream_t stream) {
  static int grid_blocks = 0;
  if (!grid_blocks) {
    (void)hipFuncSetAttribute((const void*)mega, hipFuncAttributeMaxDynamicSharedMemorySize, (int)LDS_BYTES);
    int dev = 0, cus = 0;
    (void)hipGetDevice(&dev);
    (void)hipDeviceGetAttribute(&cus, hipDeviceAttributeMultiprocessorCount, dev);
    grid_blocks = cus;
  }
  if (ws_size < 505 * MiB) { fprintf(stderr, "workspace too small: %zu\n", ws_size); return; }
  Params p{};
  p.x = (const float*)d_in[0]; p.pos = (const int*)d_in[1]; p.norm_gains = (const float*)d_in[2];
  p.ret_w_in = (const float*)d_in[3]; p.ret_decay = (const float*)d_in[4]; p.ret_w_out = (const float*)d_in[5];
  p.conv_w_in = (const float*)d_in[6]; p.conv_b_in = (const float*)d_in[7]; p.conv_w_dw = (const float*)d_in[8]; p.conv_b_dw = (const float*)d_in[9];
  p.conv_ln_g = (const float*)d_in[10]; p.conv_ln_b = (const float*)d_in[11]; p.conv_w_out = (const float*)d_in[12]; p.conv_b_out = (const float*)d_in[13];
  p.gla_w_in = (const float*)d_in[14]; p.gla_w1 = (const float*)d_in[15]; p.gla_w2 = (const float*)d_in[16]; p.gla_gb = (const float*)d_in[17];
  p.gla_ng = (const float*)d_in[18]; p.gla_w_out = (const float*)d_in[19]; p.mlp_up = (const float*)d_in[20]; p.mlp_down = (const float*)d_in[21];
  p.out = (float*)d_out; p.ws = (char*)d_ws;
  (void)hipMemsetAsync((char*)d_ws + OFF_BAR, 0, XCD_BAR_WORDS * 4, stream);
  void* args[] = {&p};
  hipError_t e = hipLaunchCooperativeKernel((void*)mega, dim3(grid_blocks), dim3(512), args, LDS_BYTES, stream);
  if (e != hipSuccess) fprintf(stderr, "cooperative launch failed: %s (grid %d)\n", hipGetErrorString(e), grid_blocks);
}
```

```cpp
#include <hip/hip_runtime.h>
#include <hip/hip_cooperative_groups.h>
#include <cstdio>
#include <cstdint>
namespace cg = cooperative_groups;

#define DI __device__ __forceinline__
typedef unsigned short bf16_t;
typedef short bf16x8 __attribute__((ext_vector_type(8)));
typedef short s16x4 __attribute__((ext_vector_type(4)));
typedef float f32x2 __attribute__((ext_vector_type(2)));
typedef float f32x4 __attribute__((ext_vector_type(4)));
typedef float f32x16 __attribute__((ext_vector_type(16)));
typedef unsigned u32x2 __attribute__((ext_vector_type(2)));
typedef unsigned u32x4 __attribute__((ext_vector_type(4)));
typedef __bf16 bf2_t __attribute__((ext_vector_type(2)));

constexpr int T_ = 32768, L_ = 8192;
constexpr float EPS = 1e-6f;
constexpr size_t MiB = 1u << 20;
constexpr size_t OFF_W = 0, OFF_A = 32 * MiB, OFF_B = 160 * MiB, OFF_C = 288 * MiB, OFF_D = 416 * MiB, OFF_P = 480 * MiB,
                 OFF_RS = 496 * MiB, OFF_E = 497 * MiB, OFF_T1 = 500 * MiB, OFF_BAR = 504 * MiB;
constexpr size_t LDS_BYTES = 163840;

struct Params {
  const float* x; const int* pos; const float* norm_gains;
  const float* ret_w_in; const float* ret_decay; const float* ret_w_out;
  const float* conv_w_in; const float* conv_b_in; const float* conv_w_dw; const float* conv_b_dw; const float* conv_ln_g; const float* conv_ln_b;
  const float* conv_w_out; const float* conv_b_out;
  const float* gla_w_in; const float* gla_w1; const float* gla_w2; const float* gla_gb; const float* gla_ng; const float* gla_w_out;
  const float* mlp_up; const float* mlp_down;
  float* out; char* ws;
};

DI unsigned pk(float lo, float hi) { f32x2 v = {lo, hi}; bf2_t b = __builtin_convertvector(v, bf2_t); return __builtin_bit_cast(unsigned, b); }
DI float bflo(unsigned w) { return __uint_as_float(w << 16); }
DI float bfhi(unsigned w) { return __uint_as_float(w & 0xffff0000u); }
DI float bf1(bf16_t h) { return __uint_as_float(((unsigned)h) << 16); }
DI bf16_t tobf(float f) { return (bf16_t)(pk(f, 0.f) & 0xffffu); }
DI float sigmoidf_(float x) { return 1.0f / (1.0f + __expf(-x)); }
DI const void* karg(int off) {
  const char* kp = (const char*)__builtin_amdgcn_kernarg_segment_ptr();
  const void* r;
  asm volatile("s_load_dwordx2 %0, %1, %2\n\ts_waitcnt lgkmcnt(0)" : "=s"(r) : "s"(kp), "s"(off) : "memory");
  return r;
}
typedef __attribute__((address_space(1))) char gchar_t;
#define KP(f) ((decltype(Params::f))(char*)(gchar_t*)(char*)karg((int)offsetof(Params, f)))
#define GAS __attribute__((address_space(1)))
template <class T> DI T gld(const void* p) { return *(const GAS T*)(const GAS char*)(const char*)p; }
template <class T> DI void gst(void* p, T v) { *(GAS T*)(GAS char*)(char*)p = v; }
DI float log_sigmoid_(float x) {
  const float e = __expf(-fabsf(x));
  const float l1p = (e < 0.0625f) ? e * (1.0f + e * (-0.5f + e * (0.33333334f + e * (-0.25f + e * (0.2f + e * (-0.16666667f + e * 0.14285715f)))))) : __logf(1.0f + e);
  return fminf(x, 0.f) - l1p;
}
DI void lds_barrier() { asm volatile("s_waitcnt lgkmcnt(0)" ::: "memory"); __builtin_amdgcn_s_barrier(); asm volatile("" ::: "memory"); }
DI int obid() { int b = blockIdx.x; asm volatile("" : "+s"(b)); return b; }
DI int otid() { int t = threadIdx.x; asm volatile("" : "+v"(t)); return t; }
DI float wave_sum(float v) {
#pragma unroll
  for (int o = 1; o < 64; o <<= 1) v += __shfl_xor(v, o);
  return v;
}


#define XB_TMO      128
#define XB_XCNT(j)  (256  + 64 * (j))
#define XB_XSUB(j)  (1280 + 64 * (j))
#define XB_XGEN(j)  (2304 + 64 * (j))
#define XB_TOP      3328
#define XB_TOPGEN   3392
#define XCD_BAR_WORDS 3456
#define XB_SPIN_CAP (1u << 18)
#define LAS __attribute__((address_space(3)))
DI unsigned xb_ld(unsigned* p)              { return __hip_atomic_load(p, __ATOMIC_RELAXED, __HIP_MEMORY_SCOPE_AGENT); }
DI unsigned xb_add(unsigned* p, unsigned v) { return __hip_atomic_fetch_add(p, v, __ATOMIC_RELAXED, __HIP_MEMORY_SCOPE_AGENT); }
DI unsigned xb_xcc_id() { return (unsigned)__builtin_amdgcn_s_getreg((3 << 11) | 20) & 0xFu; }
#define XB_SPIN(cond, bar) do { unsigned _sp = 0; while (cond) { __builtin_amdgcn_s_sleep(1); \
    if ((++_sp & 255u) == 0u) { if (xb_ld(&(bar)[XB_TMO])) break; if (_sp > XB_SPIN_CAP) { atomicAdd(&(bar)[XB_TMO], 1u); break; } } } } while (0)
struct XcdBarrier { unsigned* bar; unsigned x; volatile LAS unsigned* st; };
DI XcdBarrier xcd_barrier_post(unsigned* bar, volatile LAS unsigned* st) {
  XcdBarrier b; b.bar = bar; b.x = xb_xcc_id(); b.st = st;
  if (threadIdx.x == 0) (void)xb_add(&bar[XB_XCNT(b.x)], 1u);
  return b;
}
DI void xcd_barrier_complete(unsigned* bar, unsigned x, unsigned& nloc, unsigned& nx) {
  const unsigned G = gridDim.x * gridDim.y * gridDim.z;
  unsigned sum, cnt, mine, sp = 0u;
  for (;;) {
    sum = 0u; cnt = 0u; mine = 0u;
#pragma unroll
    for (unsigned j = 0; j < 16; ++j) { const unsigned c = xb_ld(&bar[XB_XCNT(j)]); sum += c; cnt += (c > 0u) ? 1u : 0u; mine = (j == x) ? c : mine; }
    if (sum == G) break;
    __builtin_amdgcn_s_sleep(1);
    if ((++sp & 255u) == 0u) { if (xb_ld(&bar[XB_TMO])) break; if (sp > XB_SPIN_CAP) { atomicAdd(&bar[XB_TMO], 1u); break; } }
  }
  nloc = mine > 0u ? mine : 1u; nx = cnt > 0u ? cnt : 1u;
}
DI void xcd_barrier(const XcdBarrier& b) {
  asm volatile("s_waitcnt vmcnt(0)" ::: "memory");
  __syncthreads();
  if (threadIdx.x == 0) {
    unsigned* bar = b.bar;
    __builtin_amdgcn_s_waitcnt(0);
    unsigned nloc = b.st[0], nx = b.st[1];
    if (nloc == 0u) { xcd_barrier_complete(bar, b.x, nloc, nx); b.st[0] = nloc; b.st[1] = nx; }
    const unsigned old = xb_add(&bar[XB_XSUB(b.x)], 1u);
    const unsigned gen = old / nloc;
    if (old + 1u == (gen + 1u) * nloc) {
      __builtin_amdgcn_fence(__ATOMIC_RELEASE, "agent");
      asm volatile("s_waitcnt vmcnt(0)" ::: "memory");
      const unsigned og = xb_add(&bar[XB_TOP], 1u);
      const unsigned tg = og / nx;
      if (og + 1u == (tg + 1u) * nx) xb_add(&bar[XB_TOPGEN], 1u);
      else XB_SPIN(xb_ld(&bar[XB_TOPGEN]) == tg, bar);
      __builtin_amdgcn_fence(__ATOMIC_ACQUIRE, "agent");
      xb_add(&bar[XB_XGEN(b.x)], 1u);
      asm volatile("s_waitcnt vmcnt(0)" ::: "memory");
    } else {
      XB_SPIN(xb_ld(&bar[XB_XGEN(b.x)]) == gen, bar);
      __builtin_amdgcn_fence(__ATOMIC_ACQUIRE, "agent");
      asm volatile("s_waitcnt vmcnt(0)" ::: "memory");
    }
  }
  __syncthreads();
}

DI float wsrc(const float* src, int ld, int mode, const float* aux, int k, int n) {
  if (mode == 0) return gld<float>(src + (size_t)k * ld + n);
  if (mode == 1) { int c = ((n >> 7) & 1) * 1024 + (n >> 8) * 128 + (n & 127); return gld<float>(src + (size_t)k * ld + c); }
  if (n < 2048) return gld<float>(src + (size_t)k * ld + n);
  if (n < 2080) { int j = n - 2048; return gld<float>(aux + ((size_t)(j >> 4) * 1024 + k) * 16 + (j & 15)); }
  return 0.f;
}
DI void wconv_job(const float* src, int ld, int K, int Nd, bf16_t* dst, int mode, const float* aux, float* tile, const float* gain) {
  const int tk = K >> 6, tn = Nd >> 6, nt = tk * tn, tid = otid();
  for (int t = blockIdx.x; t < nt; t += gridDim.x) {
    const int k0 = (t % tk) << 6, n0 = (t / tk) << 6;
    __syncthreads();
    if (mode == 0) {
#pragma unroll
      for (int i = 0; i < 2; ++i) {
        const int kk = (tid >> 4) + 32 * i, n4 = (tid & 15) * 4;
        f32x4 v = gld<f32x4>(src + (size_t)(k0 + kk) * ld + n0 + n4);
        if (gain) v = v * gld<float>(gain + k0 + kk);
        tile[kk * 65 + n4] = v[0]; tile[kk * 65 + n4 + 1] = v[1]; tile[kk * 65 + n4 + 2] = v[2]; tile[kk * 65 + n4 + 3] = v[3];
      }
    } else {
#pragma unroll
      for (int i = 0; i < 8; ++i) { int kk = (tid >> 6) + 8 * i, nn = tid & 63; tile[kk * 65 + nn] = wsrc(src, ld, mode, aux, k0 + kk, n0 + nn) * (gain ? gld<float>(gain + k0 + kk) : 1.0f); }
    }
    __syncthreads();
    const int nn = tid >> 3, k8 = (tid & 7) * 8;
    u32x4 w;
    w.x = pk(tile[(k8 + 0) * 65 + nn], tile[(k8 + 1) * 65 + nn]); w.y = pk(tile[(k8 + 2) * 65 + nn], tile[(k8 + 3) * 65 + nn]);
    w.z = pk(tile[(k8 + 4) * 65 + nn], tile[(k8 + 5) * 65 + nn]); w.w = pk(tile[(k8 + 6) * 65 + nn], tile[(k8 + 7) * 65 + nn]);
    gst<u32x4>(dst + (size_t)(n0 + nn) * K + k0 + k8, w);
  }
}
constexpr size_t W_IN = 0;
constexpr size_t W_G = 4096u * 1024u;
constexpr size_t W_OUT = 6144u * 1024u;
constexpr size_t W_UP = 8192u * 1024u;
constexpr size_t W_DN = 12288u * 1024u;
DI void wconv_layer(int layer, float* tile) {
  bf16_t* W = (bf16_t*)(KP(ws) + OFF_W);
  const int kind = layer % 3, j = layer / 3;
  const float* g0 = KP(norm_gains) + layer * 4096;
  const float* g2 = g0 + 2048;
  if (kind == 0) {
    const float* win = KP(ret_w_in) + (size_t)j * 1024 * 6144;
    wconv_job(win, 6144, 1024, 4096, W + W_IN, 0, nullptr, tile, g0);
    wconv_job(win + 4096, 6144, 1024, 2048, W + W_G, 0, nullptr, tile, g0);
    wconv_job(KP(ret_w_out) + (size_t)j * 2048 * 1024, 1024, 2048, 1024, W + W_OUT, 0, nullptr, tile, nullptr);
  } else if (kind == 1) {
    wconv_job(KP(conv_w_in), 2048, 1024, 2048, W + W_IN, 1, nullptr, tile, g0);
    wconv_job(KP(conv_w_out), 1024, 1024, 1024, W + W_OUT, 0, nullptr, tile, nullptr);
  } else {
    wconv_job(KP(gla_w_in), 3072, 1024, 2304, W + W_IN, 2, KP(gla_w1), tile, g0);
    wconv_job(KP(gla_w_in) + 2048, 3072, 1024, 1024, W + W_G, 0, nullptr, tile, g0);
    wconv_job(KP(gla_w_out), 1024, 1024, 1024, W + W_OUT, 0, nullptr, tile, nullptr);
  }
  wconv_job(KP(mlp_up) + (size_t)layer * 1024 * 4096, 4096, 1024, 4096, W + W_UP, 0, nullptr, tile, g2);
  wconv_job(KP(mlp_down) + (size_t)layer * 4096 * 1024, 1024, 4096, 1024, W + W_DN, 0, nullptr, tile, nullptr);
}

DI void rw_phase(const float* x, bf16_t* hb, const bf16_t* y, const float* gpost, float* rh, float* fout, bool y_unscaled) {
  const int tid_ = otid(), wid = tid_ >> 6, lane = tid_ & 63;
  for (int row = blockIdx.x * 8 + wid; row < T_; row += gridDim.x * 8) {
    float hv[16];
    if (x) {
      const float* hp = x + (size_t)row * 1024;
#pragma unroll
      for (int c = 0; c < 2; ++c) {
        const f32x4 a = gld<f32x4>(hp + 512 * c + 8 * lane), b = gld<f32x4>(hp + 512 * c + 8 * lane + 4);
        hv[8 * c + 0] = a[0]; hv[8 * c + 1] = a[1]; hv[8 * c + 2] = a[2]; hv[8 * c + 3] = a[3];
        hv[8 * c + 4] = b[0]; hv[8 * c + 5] = b[1]; hv[8 * c + 6] = b[2]; hv[8 * c + 7] = b[3];
      }
    } else {
#pragma unroll
      for (int c = 0; c < 2; ++c) {
        const u32x4 w = gld<u32x4>(hb + (size_t)row * 1024 + 512 * c + 8 * lane);
        hv[8 * c + 0] = bflo(w.x); hv[8 * c + 1] = bfhi(w.x); hv[8 * c + 2] = bflo(w.y); hv[8 * c + 3] = bfhi(w.y);
        hv[8 * c + 4] = bflo(w.z); hv[8 * c + 5] = bfhi(w.z); hv[8 * c + 6] = bflo(w.w); hv[8 * c + 7] = bfhi(w.w);
      }
    }
    if (y) {
      float yv[16]; float ss = 0.f;
#pragma unroll
      for (int c = 0; c < 2; ++c) {
        const u32x4 w = gld<u32x4>(y + (size_t)row * 1024 + 512 * c + 8 * lane);
        yv[8 * c + 0] = bflo(w.x); yv[8 * c + 1] = bfhi(w.x); yv[8 * c + 2] = bflo(w.y); yv[8 * c + 3] = bfhi(w.y);
        yv[8 * c + 4] = bflo(w.z); yv[8 * c + 5] = bfhi(w.z); yv[8 * c + 6] = bflo(w.w); yv[8 * c + 7] = bfhi(w.w);
      }
#pragma unroll
      for (int i = 0; i < 16; ++i) ss += yv[i] * yv[i];
      ss = wave_sum(ss);
      float epsn = EPS;
      if (y_unscaled) { const float r = gld<float>(rh + row), r2 = r * r; epsn = EPS / (r2 * r2); }
      const float ry = rsqrtf(ss * (1.0f / 1024.0f) + epsn);
#pragma unroll
      for (int c = 0; c < 2; ++c) {
        const f32x4 g0 = gld<f32x4>(gpost + 512 * c + 8 * lane), g1 = gld<f32x4>(gpost + 512 * c + 8 * lane + 4);
#pragma unroll
        for (int i = 0; i < 4; ++i) { hv[8 * c + i] += yv[8 * c + i] * ry * g0[i]; hv[8 * c + 4 + i] += yv[8 * c + 4 + i] * ry * g1[i]; }
      }
    }
    if (fout) {
      float* op = fout + (size_t)row * 1024;
#pragma unroll
      for (int c = 0; c < 2; ++c) {
        gst<f32x4>(op + 512 * c + 8 * lane, (f32x4){hv[8 * c], hv[8 * c + 1], hv[8 * c + 2], hv[8 * c + 3]});
        gst<f32x4>(op + 512 * c + 8 * lane + 4, (f32x4){hv[8 * c + 4], hv[8 * c + 5], hv[8 * c + 6], hv[8 * c + 7]});
      }
    } else {
      float s2 = 0.f;
#pragma unroll
      for (int c = 0; c < 2; ++c) {
        u32x4 w;
        w.x = pk(hv[8 * c + 0], hv[8 * c + 1]); w.y = pk(hv[8 * c + 2], hv[8 * c + 3]); w.z = pk(hv[8 * c + 4], hv[8 * c + 5]); w.w = pk(hv[8 * c + 6], hv[8 * c + 7]);
        gst<u32x4>(hb + (size_t)row * 1024 + 512 * c + 8 * lane, w);
        s2 += bflo(w.x) * bflo(w.x) + bfhi(w.x) * bfhi(w.x) + bflo(w.y) * bflo(w.y) + bfhi(w.y) * bfhi(w.y) +
              bflo(w.z) * bflo(w.z) + bfhi(w.z) * bfhi(w.z) + bflo(w.w) * bflo(w.w) + bfhi(w.w) * bfhi(w.w);
      }
      s2 = wave_sum(s2);
      if (lane == 0) gst<float>(rh + row, rsqrtf(s2 * (1.0f / 1024.0f) + EPS));
    }
  }
}

DI void stats_phase(const bf16_t* o, int HW, float* rs) {
  const int tid_ = otid(), wid = tid_ >> 6, lane = tid_ & 63;
  for (int row = blockIdx.x * 8 + wid; row < T_; row += gridDim.x * 8) {
    if (HW == 2048) {
#pragma unroll
      for (int c = 0; c < 4; ++c) {
        u32x4 w = gld<u32x4>(o + (size_t)row * 2048 + 512 * c + 8 * lane);
        float s = bflo(w.x) * bflo(w.x) + bfhi(w.x) * bfhi(w.x) + bflo(w.y) * bflo(w.y) + bfhi(w.y) * bfhi(w.y) +
                  bflo(w.z) * bflo(w.z) + bfhi(w.z) * bfhi(w.z) + bflo(w.w) * bflo(w.w) + bfhi(w.w) * bfhi(w.w);
        s = wave_sum(s);
        if (lane == 0) gst<float>(rs + row * 4 + c, rsqrtf(s * (1.0f / 512.0f) + EPS));
      }
    } else {
#pragma unroll
      for (int c = 0; c < 2; ++c) {
        u32x4 w = gld<u32x4>(o + (size_t)row * 1024 + 512 * c + 8 * lane);
        float s = bflo(w.x) * bflo(w.x) + bfhi(w.x) * bfhi(w.x) + bflo(w.y) * bflo(w.y) + bfhi(w.y) * bfhi(w.y) +
                  bflo(w.z) * bflo(w.z) + bfhi(w.z) * bfhi(w.z) + bflo(w.w) * bflo(w.w) + bfhi(w.w) * bfhi(w.w);
#pragma unroll
        for (int of = 1; of < 32; of <<= 1) s += __shfl_xor(s, of);
        if ((lane & 31) == 0) gst<float>(rs + row * 4 + 2 * c + (lane >> 5), rsqrtf(s * (1.0f / 256.0f) + EPS));
      }
    }
  }
}

constexpr int BM = 256, BK = 64, HALF = 128, NXCD = 8, WGM = 4, HT = HALF * BK;
enum { EPI_PLAIN = 0, EPI_RELU2 = 1, EPI_RETQKV = 2, EPI_GATE = 3, EPI_GLU = 4, EPI_GLA = 5 };
struct GemmDesc {
  const bf16_t* A; const bf16_t* Bt; int N; int K; int epi; int dvshift;
  bf16_t* o0; bf16_t* o1; float* f0; const float* bias; const float* c0; const int* pos; const float* rowscale;
};
DI int lds_byte(int r, int c) { int st = (r >> 4) * 2 + (c >> 5), rr = r & 15, cc = c & 31, ob = rr * 64 + cc * 2; return st * 1024 + (ob ^ (((ob >> 9) & 1) << 5)); }
DI void stage_rc(int b, int& R, int& C) { int st = b / 1024, sb = b % 1024, swz = sb ^ (((sb >> 9) & 1) << 5); R = (st >> 1) * 16 + swz / 64; C = (st & 1) * 32 + (swz % 64) / 2; }

DI void gemm_epilogue(const GemmDesc& g, f32x4 (&acc)[2][2][4][2], int brow, int bcol, int wr, int wc, int fr, int fq) {
  const int epi = g.epi;
  const int rowb = brow + wr * 64 + fr, colb = bcol + wc * 32 + 8 * fq;
  if (epi == EPI_PLAIN || epi == EPI_RELU2) {
    const int N = g.N;
#pragma unroll
    for (int bj = 0; bj < 2; ++bj) {
      const int col = colb + bj * HALF;
      f32x4 b0 = {0.f, 0.f, 0.f, 0.f}, b1 = b0;
      if (g.bias) { b0 = gld<f32x4>(g.bias + col); b1 = gld<f32x4>(g.bias + col + 4); }
#pragma unroll
      for (int ai = 0; ai < 2; ++ai)
#pragma unroll
        for (int m = 0; m < 4; ++m) {
          const int row = rowb + ai * HALF + m * 16;
          f32x4 v0 = acc[ai][bj][m][0], v1 = acc[ai][bj][m][1];
          if (g.rowscale) { const float ru = gld<float>(g.rowscale + row); v0 = v0 * ru; v1 = v1 * ru; }
          v0 = v0 + b0; v1 = v1 + b1;
          if (epi == EPI_RELU2) {
#pragma unroll
            for (int j = 0; j < 4; ++j) { float r0 = fmaxf(v0[j], 0.f), r1 = fmaxf(v1[j], 0.f); v0[j] = r0 * r0; v1[j] = r1 * r1; }
          }
          u32x4 w; w.x = pk(v0[0], v0[1]); w.y = pk(v0[2], v0[3]); w.z = pk(v1[0], v1[1]); w.w = pk(v1[2], v1[3]);
          gst<u32x4>(g.o0 + (size_t)row * N + col, w);
        }
    }
  } else if (epi == EPI_RETQKV) {
    if (bcol < 2048) {
      const float sc = (bcol < 1024) ? 0.0625f : 1.0f;
      const int d0 = wc * 32 + 8 * fq;
      float fr_[8];
#pragma unroll
      for (int j = 0; j < 8; ++j) fr_[j] = exp2f(-(float)(d0 + j) * (13.287712379549449f / 128.0f)) * 0.15915494309189535f;
#pragma unroll
      for (int ai = 0; ai < 2; ++ai)
#pragma unroll
        for (int m = 0; m < 4; ++m) {
          const int row = rowb + ai * HALF + m * 16;
          const float pf = (float)gld<int>(g.pos + row);
          const float scr = sc * gld<float>(g.rowscale + row);
          float y1[8], y2[8];
#pragma unroll
          for (int n = 0; n < 2; ++n) {
            const f32x4 x1 = acc[ai][0][m][n], x2 = acc[ai][1][m][n];
#pragma unroll
            for (int j = 0; j < 4; ++j) {
              float rev = pf * fr_[4 * n + j]; rev = rev - rintf(rev);
              const float sn = __builtin_amdgcn_sinf(rev), cs = __builtin_amdgcn_cosf(rev);
              y1[4 * n + j] = (x1[j] * cs - x2[j] * sn) * scr; y2[4 * n + j] = (x2[j] * cs + x1[j] * sn) * scr;
            }
          }
          u32x4 w1, w2;
          w1.x = pk(y1[0], y1[1]); w1.y = pk(y1[2], y1[3]); w1.z = pk(y1[4], y1[5]); w1.w = pk(y1[6], y1[7]);
          w2.x = pk(y2[0], y2[1]); w2.y = pk(y2[2], y2[3]); w2.z = pk(y2[4], y2[5]); w2.w = pk(y2[6], y2[7]);
          bf16_t* op = g.o0 + (size_t)row * 2048 + bcol + d0;
          gst<u32x4>(op, w1); gst<u32x4>(op + 128, w2);
        }
    } else {
#pragma unroll
      for (int bj = 0; bj < 2; ++bj) {
        const int col = colb - 2048 + bj * HALF;
#pragma unroll
        for (int ai = 0; ai < 2; ++ai)
#pragma unroll
          for (int m = 0; m < 4; ++m) {
            const int row = rowb + ai * HALF + m * 16;
            const float ru = gld<float>(g.rowscale + row);
            const f32x4 v0 = acc[ai][bj][m][0] * ru, v1 = acc[ai][bj][m][1] * ru;
            u32x4 w; w.x = pk(v0[0], v0[1]); w.y = pk(v0[2], v0[3]); w.z = pk(v1[0], v1[1]); w.w = pk(v1[2], v1[3]);
            gst<u32x4>(g.o1 + (size_t)row * 2048 + col, w);
          }
      }
    }
  } else if (epi == EPI_GATE) {
    const int N = g.N, dvm = (1 << g.dvshift) - 1;
#pragma unroll
    for (int bj = 0; bj < 2; ++bj) {
      const int col = colb + bj * HALF;
      f32x4 g0 = {1.f, 1.f, 1.f, 1.f}, g1 = g0;
      if (g.c0) { g0 = gld<f32x4>(g.c0 + (col & dvm)); g1 = gld<f32x4>(g.c0 + (col & dvm) + 4); }
      const int head = col >> g.dvshift;
#pragma unroll
      for (int ai = 0; ai < 2; ++ai)
#pragma unroll
        for (int m = 0; m < 4; ++m) {
          const int row = rowb + ai * HALF + m * 16;
          float rs;
          { const float* sp = g.f0 + (size_t)row * 32 + head * 8;
            const f32x4 s0 = gld<f32x4>(sp); float ssum = (s0[0] + s0[1]) + (s0[2] + s0[3]);
            if (g.dvshift == 9) { const f32x4 s1 = gld<f32x4>(sp + 4); ssum += (s1[0] + s1[1]) + (s1[2] + s1[3]); }
            rs = rsqrtf(ssum * (g.dvshift == 9 ? (1.0f / 512.0f) : (1.0f / 256.0f)) + EPS); }
          bf16_t* op = g.o0 + (size_t)row * N + col;
          const u32x4 ow = gld<u32x4>(op);
          const float ru = gld<float>(g.rowscale + row);
          const f32x4 v0 = acc[ai][bj][m][0] * ru, v1 = acc[ai][bj][m][1] * ru;
          float o[8] = {bflo(ow.x), bfhi(ow.x), bflo(ow.y), bfhi(ow.y), bflo(ow.z), bfhi(ow.z), bflo(ow.w), bfhi(ow.w)};
#pragma unroll
          for (int j = 0; j < 4; ++j) { o[j] = o[j] * rs * g0[j] * v0[j] * sigmoidf_(v0[j]); o[4 + j] = o[4 + j] * rs * g1[j] * v1[j] * sigmoidf_(v1[j]); }
          u32x4 w; w.x = pk(o[0], o[1]); w.y = pk(o[2], o[3]); w.z = pk(o[4], o[5]); w.w = pk(o[6], o[7]);
          gst<u32x4>(op, w);
        }
    }
  } else if (epi == EPI_GLU) {
    const int ca = 128 * (bcol >> 8) + wc * 32 + 8 * fq;
    const f32x4 ba0 = gld<f32x4>(g.bias + ca), ba1 = gld<f32x4>(g.bias + ca + 4);
    const f32x4 bg0 = gld<f32x4>(g.bias + 1024 + ca), bg1 = gld<f32x4>(g.bias + 1024 + ca + 4);
#pragma unroll
    for (int ai = 0; ai < 2; ++ai)
#pragma unroll
      for (int m = 0; m < 4; ++m) {
        const int row = rowb + ai * HALF + m * 16;
        const float ru = gld<float>(g.rowscale + row);
        const f32x4 a0 = acc[ai][0][m][0] * ru + ba0, a1 = acc[ai][0][m][1] * ru + ba1, t0 = acc[ai][1][m][0] * ru + bg0, t1 = acc[ai][1][m][1] * ru + bg1;
        float o[8];
#pragma unroll
        for (int j = 0; j < 4; ++j) { o[j] = a0[j] * sigmoidf_(t0[j]); o[4 + j] = a1[j] * sigmoidf_(t1[j]); }
        u32x4 w; w.x = pk(o[0], o[1]); w.y = pk(o[2], o[3]); w.z = pk(o[4], o[5]); w.w = pk(o[6], o[7]);
        gst<u32x4>(g.o0 + (size_t)row * 1024 + ca, w);
      }
  } else {
#pragma unroll
    for (int bj = 0; bj < 2; ++bj) {
      const int col = colb + bj * HALF;
#pragma unroll
      for (int ai = 0; ai < 2; ++ai)
#pragma unroll
        for (int m = 0; m < 4; ++m) {
          const int row = rowb + ai * HALF + m * 16;
          const float ru = gld<float>(g.rowscale + row);
          f32x4 v0 = acc[ai][bj][m][0] * ru, v1 = acc[ai][bj][m][1] * ru;
          if (bcol < 2048) {
            if (bcol < 512) { v0 = v0 * 0.08838834764831845f; v1 = v1 * 0.08838834764831845f; }
            bf16_t* base = (bcol < 1024) ? (g.o0 + (size_t)row * 1024 + col) : (g.o1 + (size_t)row * 1024 + (col - 1024));
            u32x4 w; w.x = pk(v0[0], v0[1]); w.y = pk(v0[2], v0[3]); w.z = pk(v1[0], v1[1]); w.w = pk(v1[2], v1[3]);
            gst<u32x4>(base, w);
          } else if (col < 2080) {
            gst<f32x4>(g.f0 + (size_t)row * 32 + (col - 2048), v0); gst<f32x4>(g.f0 + (size_t)row * 32 + (col - 2048) + 4, v1);
          }
        }
    }
  }
}

DI int perm32(int rho) { const int n = rho >> 4, i = rho & 15; return 8 * (i >> 2) + 4 * n + (i & 3); }
DI bool tile_next(int i, int G, int c, int nM, int nN, int& pm, int& pn) {
  const int nwg = nM * nN; const long L = (long)i * G + c; if (L >= nwg) return false;
  int wgid = (int)L; { const int q = nwg / NXCD, r = nwg % NXCD, xcd = wgid % NXCD, off = wgid / NXCD; wgid = (xcd < r ? xcd * (q + 1) : r * (q + 1) + (xcd - r) * q) + off; }
  const int nig = WGM * nN, gid = wgid / nig, fm = gid * WGM, gsz = (nM - fm) < WGM ? (nM - fm) : WGM;
  pm = fm + ((wgid % nig) % gsz); pn = (wgid % nig) / gsz; return true;
}
DI void gemm_phase(const GemmDesc& g, LAS unsigned char* lds) {
  constexpr int HTB = HALF * BK * 2;
  const int tid = otid(), wid = __builtin_amdgcn_readfirstlane(tid >> 6), lane = tid & 63, wr = wid >> 2, wc = wid & 3, fr = lane & 15, fq = lane >> 4;
  const int K = g.K, nt = K / BK, nM = T_ / BM, nN = g.N / BM, G = gridDim.x, cb = blockIdx.x;
  unsigned voffA[2], voffB[2];
#pragma unroll
  for (int i = 0; i < 2; ++i) { int R, C; stage_rc(tid * 16 + i * 8192, R, C); const int Rb = (R & ~31) + perm32(R & 31);
    voffA[i] = (unsigned)(R * K + C) * 2u; voffB[i] = (unsigned)(Rb * K + C) * 2u; }
  const size_t kstep = (size_t)(BK * 2), hstep = (size_t)HALF * K * 2, tstep = 2 * hstep;
  const unsigned ldsw = (unsigned)wid * 1024u;
  const int aoff = lds_byte(wr * 64 + fr, fq * 8), boff = lds_byte(wc * 32 + fr, fq * 8);
#define PG8_SA(b, h) (((b) * 2 + (h)) * HTB)
#define PG8_SB(b, h) ((4 + (b) * 2 + (h)) * HTB)
#define PG8_STAGE(bufoff, gbase, voff) do { _Pragma("unroll") for (int _i = 0; _i < 2; ++_i) \
    __builtin_amdgcn_global_load_lds((const unsigned*)((const char*)(gbase) + (voff)[_i]), (LAS unsigned*)(lds + (bufoff) + ldsw + _i * 8192), 16, 0, 0); } while (0)
#define PG8_LDA(dst, b, h) do { _Pragma("unroll") for (int m = 0; m < 4; ++m) _Pragma("unroll") for (int k = 0; k < 2; ++k) dst[m][k] = *(const LAS bf16x8*)(lds + PG8_SA(b, h) + aoff + m * 2048 + k * 1024); } while (0)
#define PG8_LDB(dst, b, h) do { _Pragma("unroll") for (int n = 0; n < 2; ++n) _Pragma("unroll") for (int k = 0; k < 2; ++k) dst[n][k] = *(const LAS bf16x8*)(lds + PG8_SB(b, h) + boff + n * 2048 + k * 1024); } while (0)
#define PG8_MMA(ai, bj, At, Bt) do { __builtin_amdgcn_s_setprio(1); _Pragma("unroll") for (int m = 0; m < 4; ++m) _Pragma("unroll") for (int n = 0; n < 2; ++n) _Pragma("unroll") for (int k = 0; k < 2; ++k) \
    acc[ai][bj][m][n] = __builtin_amdgcn_mfma_f32_16x16x32_bf16(Bt[n][k], At[m][k], acc[ai][bj][m][n], 0, 0, 0); __builtin_amdgcn_s_setprio(0); } while (0)
#define PG8_WAIT_V(n) asm volatile("s_waitcnt vmcnt(" #n ")" ::: "memory")
#define PG8_WAIT_L(n) asm volatile("s_waitcnt lgkmcnt(" #n ")" ::: "memory")
#define PG8_BAR __builtin_amdgcn_s_barrier()
#define PG8_SCHED __builtin_amdgcn_sched_barrier(0)
  int cpm, cpn, npm = 0, npn = 0, ui = 0;
  if (!tile_next(0, G, cb, nM, nN, cpm, cpn)) return;
  f32x4 acc[2][2][4][2];
#pragma unroll
  for (int a = 0; a < 2; ++a)
#pragma unroll
    for (int b = 0; b < 2; ++b)
#pragma unroll
      for (int m = 0; m < 4; ++m)
#pragma unroll
        for (int n = 0; n < 2; ++n) acc[a][b][m][n] = (f32x4){0.f, 0.f, 0.f, 0.f};
  bf16x8 At[4][2], B0[2][2], B1[2][2];
  const char* cA = (const char*)g.A + (size_t)cpm * tstep; const char* cB = (const char*)g.Bt + (size_t)cpn * tstep;
  PG8_STAGE(PG8_SB(0, 0), cB, voffB); PG8_STAGE(PG8_SB(0, 1), cB + hstep, voffB); PG8_STAGE(PG8_SA(0, 0), cA, voffA); PG8_STAGE(PG8_SA(0, 1), cA + hstep, voffA);
  if (wr == 1) PG8_BAR;
  PG8_WAIT_V(2); PG8_BAR;
  PG8_STAGE(PG8_SB(1, 0), cB + kstep, voffB); PG8_STAGE(PG8_SA(1, 0), cA + kstep, voffA); PG8_STAGE(PG8_SB(1, 1), cB + hstep + kstep, voffB);
  PG8_WAIT_V(6); PG8_BAR;
  for (;;) {
    const bool has_next = tile_next(ui + 1, G, cb, nM, nN, npm, npn);
    const char* nA = has_next ? (const char*)g.A + (size_t)npm * tstep : cA; const char* nB = has_next ? (const char*)g.Bt + (size_t)npn * tstep : cB;
    for (int t = 0; t < nt; t += 2) {
      const bool last = (t == nt - 2);
      const char* a1 = cA + (size_t)(t + 1) * kstep;
      const char* a2 = last ? nA : cA + (size_t)(t + 2) * kstep; const char* b2 = last ? nB : cB + (size_t)(t + 2) * kstep;
      const char* a3 = a2 + kstep; const char* b3 = b2 + kstep;
      PG8_LDB(B0, 0, 0); PG8_LDB(B1, 0, 1); PG8_SCHED; PG8_LDA(At, 0, 0); PG8_STAGE(PG8_SA(1, 1), a1 + hstep, voffA);
      PG8_WAIT_V(8); PG8_WAIT_L(0); PG8_BAR; PG8_MMA(0, 0, At, B0); PG8_MMA(0, 1, At, B1); PG8_BAR; PG8_SCHED;
      PG8_LDA(At, 0, 1); PG8_STAGE(PG8_SB(0, 0), b2, voffB); PG8_STAGE(PG8_SB(0, 1), b2 + hstep, voffB); PG8_STAGE(PG8_SA(0, 0), a2, voffA);
      PG8_WAIT_V(8); PG8_WAIT_L(0); PG8_BAR; PG8_MMA(1, 0, At, B0); PG8_MMA(1, 1, At, B1); PG8_BAR; PG8_SCHED;
      PG8_LDB(B0, 1, 0); PG8_LDB(B1, 1, 1); PG8_SCHED; PG8_LDA(At, 1, 0); PG8_STAGE(PG8_SA(0, 1), a2 + hstep, voffA);
      PG8_WAIT_V(8); PG8_WAIT_L(0); PG8_BAR; PG8_MMA(0, 0, At, B0); PG8_MMA(0, 1, At, B1); PG8_BAR; PG8_SCHED;
      PG8_LDA(At, 1, 1); PG8_STAGE(PG8_SB(1, 0), b3, voffB); PG8_STAGE(PG8_SB(1, 1), b3 + hstep, voffB); PG8_STAGE(PG8_SA(1, 0), a3, voffA);
      PG8_WAIT_V(8); PG8_WAIT_L(0); PG8_BAR; PG8_MMA(1, 0, At, B0); PG8_MMA(1, 1, At, B1); PG8_BAR; PG8_SCHED;
    }
    if (wr == 0) PG8_BAR;
    gemm_epilogue(g, acc, cpm * BM, cpn * BM, wr, wc, fr, fq);
    if (!has_next) break;
#pragma unroll
    for (int a = 0; a < 2; ++a)
#pragma unroll
      for (int b = 0; b < 2; ++b)
#pragma unroll
        for (int m = 0; m < 4; ++m)
#pragma unroll
          for (int n = 0; n < 2; ++n) acc[a][b][m][n] = (f32x4){0.f, 0.f, 0.f, 0.f};
    cpm = npm; cpn = npn; cA = nA; cB = nB; ++ui;
    if (wr == 1) PG8_BAR;
  }
  PG8_WAIT_V(0);
  PG8_BAR;
}

template <int R> DI void conv_row(f32x2 (&acc)[32], const f32x2 (&wt)[31], const unsigned* tile, int tid) {
  const unsigned x = tile[R * 512 + tid];
  const f32x2 xv = {bflo(x), bfhi(x)};
#pragma unroll
  for (int i = 0; i < 32; ++i) { if (R - i >= 0 && R - i < 31) acc[i] = acc[i] + xv * wt[(R - i >= 0 && R - i < 31) ? R - i : 0]; }
  if ((R & 7) == 7) asm volatile("" ::: "memory");
}
template <int R0, int N> struct ConvRows {
  static DI void run(f32x2 (&acc)[32], const f32x2 (&wt)[31], const unsigned* tile, int tid) { conv_row<R0>(acc, wt, tile, tid); ConvRows<R0 + 1, N - 1>::run(acc, wt, tile, tid); }
};
template <int R0> struct ConvRows<R0, 0> { static DI void run(f32x2 (&)[32], const f32x2 (&)[31], const unsigned*, int) {} };
DI void conv_phase(const bf16_t* hc, bf16_t* hn, char* lds) {
  const float* wdw = KP(conv_w_dw);
  const int tid = otid();
  unsigned* tile = (unsigned*)lds;
  float* red = (float*)lds;
  unsigned toff = 131072; asm volatile("" : "+s"(toff));
  float* tot = (float*)(lds + toff);
  const f32x2 bdw = gld<f32x2>(KP(conv_b_dw) + 2 * tid);
  const f32x2 lg = gld<f32x2>(KP(conv_ln_g) + 2 * tid), lb = gld<f32x2>(KP(conv_ln_b) + 2 * tid);
  for (int item = blockIdx.x; item < T_ / 32; item += gridDim.x) {
    const int b = item >> 8, t0 = (item & 255) * 32;
    __syncthreads();
#pragma unroll
    for (int hf = 0; hf < 2; ++hf) {
      u32x4 w[8];
#pragma unroll
      for (int i = 0; i < 8; ++i) {
        const int c = tid + 512 * (8 * hf + i), r = c >> 7, ch = c & 127, t = t0 - 15 + r;
        w[i] = (u32x4){0u, 0u, 0u, 0u};
        if (r < 62 && t >= 0 && t < L_) w[i] = gld<u32x4>(hc + ((size_t)(b * L_ + t)) * 1024 + ch * 8);
      }
#pragma unroll
      for (int i = 0; i < 8; ++i) {
        const int c = tid + 512 * (8 * hf + i), r = c >> 7, ch = c & 127;
        if (r < 62) *(u32x4*)(tile + r * 512 + ch * 4) = w[i];
      }
      asm volatile("" ::: "memory");
    }
    __syncthreads();
    const float* wd2 = wdw; asm volatile("" : "+s"(wd2));
    f32x2 acc[32], wt[31];
#pragma unroll
    for (int i = 0; i < 32; ++i) acc[i] = bdw;
#pragma unroll
    for (int j = 0; j < 31; ++j) wt[j] = gld<f32x2>(wd2 + j * 1024 + 2 * tid);
    ConvRows<0, 62>::run(acc, wt, tile, tid);
    __syncthreads();
#pragma unroll
    for (int i = 0; i < 32; ++i) { red[i * 512 + tid] = acc[i].x + acc[i].y; red[(32 + i) * 512 + tid] = acc[i].x * acc[i].x + acc[i].y * acc[i].y; }
    __syncthreads();
    {
      const int q = tid >> 3, part = tid & 7;
      float sm = 0.f;
#pragma unroll
      for (int i = 0; i < 16; ++i) { f32x4 v = *(const f32x4*)(red + q * 512 + part * 64 + i * 4); sm += (v[0] + v[1]) + (v[2] + v[3]); }
      sm += __shfl_xor(sm, 1); sm += __shfl_xor(sm, 2); sm += __shfl_xor(sm, 4);
      if (part == 0) tot[q] = sm;
    }
    __syncthreads();
#pragma unroll
    for (int i = 0; i < 32; ++i) {
      const float mu = tot[i] * (1.0f / 1024.0f), var = fmaxf(tot[32 + i] * (1.0f / 1024.0f) - mu * mu, 0.f), rstd = rsqrtf(var + EPS);
      float y0 = (acc[i].x - mu) * rstd * lg.x + lb.x, y1 = (acc[i].y - mu) * rstd * lg.y + lb.y;
      y0 = y0 * sigmoidf_(y0); y1 = y1 * sigmoidf_(y1);
      gst<unsigned>(hn + ((size_t)(b * L_ + t0 + i)) * 1024 + 2 * tid, pk(y0, y1));
    }
  }
}

DI void glaprep_phase(const bf16_t* qk, const float* t1, bf16_t* QKf, bf16_t* QKb, float* E, char* lds) {
  const int tid = otid();
  float* t1s = (float*)lds;
  bf16_t* raw = (bf16_t*)(lds + 8192);
  float w2f[16], w2b[16];
  const float* gw2 = KP(gla_w2); const float* ggb = KP(gla_gb);
#pragma unroll
  for (int r = 0; r < 16; ++r) { w2f[r] = gld<float>(gw2 + r * 512 + tid); w2b[r] = gld<float>(gw2 + (16 + r) * 512 + tid); }
  const float bf_ = gld<float>(ggb + tid), bb_ = gld<float>(ggb + 512 + tid);
  for (int item = blockIdx.x; item < T_ / 64; item += gridDim.x) {
    const size_t tok0 = (size_t)item * 64;
    __syncthreads();
    {
      u32x4 w[16];
#pragma unroll
      for (int i = 0; i < 16; ++i) w[i] = gld<u32x4>(qk + tok0 * 1024 + (size_t)(tid + 512 * i) * 8);
      const f32x4 tv = gld<f32x4>(t1 + tok0 * 32 + tid * 4);
#pragma unroll
      for (int i = 0; i < 16; ++i) *(u32x4*)(raw + (size_t)(tid + 512 * i) * 8) = w[i];
      *(f32x4*)(t1s + tid * 4) = tv;
    }
    __syncthreads();
    float c = 0.f;
#pragma unroll 8
    for (int i = 0; i < 64; ++i) {
      float lgt = bf_;
#pragma unroll
      for (int r = 0; r < 16; ++r) lgt += t1s[i * 32 + r] * w2f[r];
      c += log_sigmoid_(lgt) * (1.0f / 16.0f);
      const float qv = bf1(raw[i * 1024 + tid]), kv = bf1(raw[i * 1024 + 512 + tid]);
      gst<bf16_t>(QKf + (tok0 + i) * 1024 + tid, tobf(qv * __expf(c)));
      gst<bf16_t>(QKf + (tok0 + i) * 1024 + 512 + tid, tobf(kv * __expf(-c)));
    }
    gst<float>(E + (size_t)item * 512 + tid, __expf(c));
    c = 0.f;
#pragma unroll 8
    for (int i = 63; i >= 0; --i) {
      float lgt = bb_;
#pragma unroll
      for (int r = 0; r < 16; ++r) lgt += t1s[i * 32 + 16 + r] * w2b[r];
      c += log_sigmoid_(lgt) * (1.0f / 16.0f);
      const float qv = bf1(raw[i * 1024 + tid]), kv = bf1(raw[i * 1024 + 512 + tid]);
      gst<bf16_t>(QKb + (tok0 + i) * 1024 + tid, tobf(qv * __expf(c)));
      gst<bf16_t>(QKb + (tok0 + i) * 1024 + 512 + tid, tobf(kv * __expf(-c)));
    }
    gst<float>(E + (size_t)(T_ / 64) * 512 + (size_t)item * 512 + tid, __expf(c));
  }
}

template <int DK, bool GLA>
DI void ppass_phase(const bf16_t* Qf, const bf16_t* Kf, const bf16_t* Qb, const bf16_t* Kb, int ld, const float* decay, bf16_t* P) {
  const int tid_ = otid(), wid = tid_ >> 6, lane = tid_ & 63, fr = lane & 15, fq = lane >> 4;
  const int rt = wid >> 1, ct0 = 2 * (wid & 1);
  for (int item = blockIdx.x; item < 2048; item += gridDim.x) {
    const int n = item & 127, h = (item >> 7) & 3, b = item >> 9;
    const size_t tok0 = (size_t)b * L_ + n * 64;
    f32x4 xf[2] = {}, xb[2] = {};
    const bf16_t* qa = Qf + (tok0 + 16 * rt + fr) * ld + h * DK + 8 * fq;
    const bf16_t* ka0 = Kf + (tok0 + 16 * ct0 + fr) * ld + h * DK + 8 * fq;
    const bf16_t* ka1 = ka0 + (size_t)16 * ld;
#pragma unroll
    for (int kk = 0; kk < DK / 32; ++kk) {
      const bf16x8 a = gld<bf16x8>(qa + 32 * kk), b0 = gld<bf16x8>(ka0 + 32 * kk), b1 = gld<bf16x8>(ka1 + 32 * kk);
      xf[0] = __builtin_amdgcn_mfma_f32_16x16x32_bf16(a, b0, xf[0], 0, 0, 0);
      xf[1] = __builtin_amdgcn_mfma_f32_16x16x32_bf16(a, b1, xf[1], 0, 0, 0);
    }
    if (GLA) {
      const bf16_t* qb = Qb + (tok0 + 16 * rt + fr) * ld + h * DK + 8 * fq;
      const bf16_t* kb0 = Kb + (tok0 + 16 * ct0 + fr) * ld + h * DK + 8 * fq;
      const bf16_t* kb1 = kb0 + (size_t)16 * ld;
#pragma unroll
      for (int kk = 0; kk < DK / 32; ++kk) {
        const bf16x8 a = gld<bf16x8>(qb + 32 * kk), b0 = gld<bf16x8>(kb0 + 32 * kk), b1 = gld<bf16x8>(kb1 + 32 * kk);
        xb[0] = __builtin_amdgcn_mfma_f32_16x16x32_bf16(a, b0, xb[0], 0, 0, 0);
        xb[1] = __builtin_amdgcn_mfma_f32_16x16x32_bf16(a, b1, xb[1], 0, 0, 0);
      }
    }
    bf16_t* Po = P + (size_t)item * 4096;
    Po = P + ((size_t)((b * 128 + n) * 4 + h)) * 4096;
#pragma unroll
    for (int c = 0; c < 2; ++c)
#pragma unroll
      for (int j = 0; j < 4; ++j) {
        const int i = 16 * rt + 4 * fq + j, s = 16 * (ct0 + c) + fr;
        float v;
        if (GLA) v = (s <= i) ? xf[c][j] : xb[c][j];
        else v = xf[c][j];
        gst<bf16_t>(Po + i * 64 + s, tobf(v));
      }
  }
}

struct FalseC { static constexpr bool value = false; }; struct TrueC { static constexpr bool value = true; };
struct ScanArgs {
  const bf16_t* q0; const bf16_t* q1; const bf16_t* k0; const bf16_t* k1;
  const bf16_t* v; const bf16_t* P; bf16_t* o;
  const float* E;
  const float* decay;
  float* ssp;
};
DI s16x4 tr_read(unsigned a) { s16x4 r; asm volatile("ds_read_b64_tr_b16 %0, %1\n\ts_waitcnt lgkmcnt(0)" : "=&v"(r) : "v"(a) : "memory"); return r; }
template <int SA_, int SB_>
DI void tr_read8(unsigned a, s16x4 (&r)[8]) {
  asm volatile("ds_read_b64_tr_b16 %0, %8 offset:%9\n\tds_read_b64_tr_b16 %1, %8 offset:%10\n\tds_read_b64_tr_b16 %2, %8 offset:%11\n\tds_read_b64_tr_b16 %3, %8 offset:%12\n\t"
               "ds_read_b64_tr_b16 %4, %8 offset:%13\n\tds_read_b64_tr_b16 %5, %8 offset:%14\n\tds_read_b64_tr_b16 %6, %8 offset:%15\n\tds_read_b64_tr_b16 %7, %8 offset:%16\n\t"
               "s_waitcnt lgkmcnt(0)"
               : "=&v"(r[0]), "=&v"(r[1]), "=&v"(r[2]), "=&v"(r[3]), "=&v"(r[4]), "=&v"(r[5]), "=&v"(r[6]), "=&v"(r[7])
               : "v"(a), "n"(0), "n"(SA_), "n"(SB_), "n"(SB_ + SA_), "n"(2 * SB_), "n"(2 * SB_ + SA_), "n"(3 * SB_), "n"(3 * SB_ + SA_)
               : "memory");
}
template <int SA_, int SB_>
DI void tr_issue8(unsigned a, s16x4 (&r)[8]) {
  asm volatile("ds_read_b64_tr_b16 %0, %8 offset:%9\n\tds_read_b64_tr_b16 %1, %8 offset:%10\n\tds_read_b64_tr_b16 %2, %8 offset:%11\n\tds_read_b64_tr_b16 %3, %8 offset:%12\n\t"
               "ds_read_b64_tr_b16 %4, %8 offset:%13\n\tds_read_b64_tr_b16 %5, %8 offset:%14\n\tds_read_b64_tr_b16 %6, %8 offset:%15\n\tds_read_b64_tr_b16 %7, %8 offset:%16"
               : "=&v"(r[0]), "=&v"(r[1]), "=&v"(r[2]), "=&v"(r[3]), "=&v"(r[4]), "=&v"(r[5]), "=&v"(r[6]), "=&v"(r[7])
               : "v"(a), "n"(0), "n"(SA_), "n"(SB_), "n"(SB_ + SA_), "n"(2 * SB_), "n"(2 * SB_ + SA_), "n"(3 * SB_), "n"(3 * SB_ + SA_)
               : "memory");
}
template <int SA_>
DI void tr_issue2(unsigned a, s16x4 (&r)[2]) {
  asm volatile("ds_read_b64_tr_b16 %0, %2\n\tds_read_b64_tr_b16 %1, %2 offset:%3" : "=&v"(r[0]), "=&v"(r[1]) : "v"(a), "n"(SA_) : "memory");
}
DI void tr_wait10(s16x4 (&a)[8], s16x4 (&b)[2]) {
  asm volatile("s_waitcnt lgkmcnt(0)" : "+v"(a[0]), "+v"(a[1]), "+v"(a[2]), "+v"(a[3]), "+v"(a[4]), "+v"(a[5]), "+v"(a[6]), "+v"(a[7]), "+v"(b[0]), "+v"(b[1]) :: "memory");
}
DI void tr_wait8(s16x4 (&a)[8]) {
  asm volatile("s_waitcnt lgkmcnt(0)" : "+v"(a[0]), "+v"(a[1]), "+v"(a[2]), "+v"(a[3]), "+v"(a[4]), "+v"(a[5]), "+v"(a[6]), "+v"(a[7]) :: "memory");
}
DI void tr_wait16(s16x4 (&a)[8], s16x4 (&b)[8]) {
  asm volatile("s_waitcnt lgkmcnt(0)" : "+v"(a[0]), "+v"(a[1]), "+v"(a[2]), "+v"(a[3]), "+v"(a[4]), "+v"(a[5]), "+v"(a[6]), "+v"(a[7]),
               "+v"(b[0]), "+v"(b[1]), "+v"(b[2]), "+v"(b[3]), "+v"(b[4]), "+v"(b[5]), "+v"(b[6]), "+v"(b[7]) :: "memory");
}
DI bf16x8 cat8(s16x4 a, s16x4 b) { bf16x8 r; r[0] = a[0]; r[1] = a[1]; r[2] = a[2]; r[3] = a[3]; r[4] = b[0]; r[5] = b[1]; r[6] = b[2]; r[7] = b[3]; return r; }
DI u32x4 scale8(u32x4 w, float s) {
  u32x4 r; r.x = pk(bflo(w.x) * s, bfhi(w.x) * s); r.y = pk(bflo(w.y) * s, bfhi(w.y) * s); r.z = pk(bflo(w.z) * s, bfhi(w.z) * s); r.w = pk(bflo(w.w) * s, bfhi(w.w) * s); return r;
}
template <int DK>
DI void scan_phase(const ScanArgs& a, char* lds, const XcdBarrier& xb) {
  constexpr int QS = DK * 2 + 16, KS = DK * 2 + 64, VS = 192, PS = 144, NQ = DK / 128 * 2;
  constexpr int RW = DK / 4, NT = RW / 32;
  constexpr int LDQK = (DK == 256) ? 2048 : 1024, LDV = LDQK, LDO = LDQK, DVH = 2 * DK;
  constexpr bool ret = (DK == 256);
  constexpr int OFF_K = 64 * QS, OFF_V = OFF_K + 64 * KS, OFF_PP = OFF_V + 64 * VS, OFF_O = OFF_PP + 64 * PS, OFF_EE = OFF_O + 65536, OFF_SC = OFF_EE + DK * 4;
  static_assert(OFF_SC + 512 <= (int)LDS_BYTES - 16, "LDS budget");
  const int tid = otid(), wid = tid >> 6, lane = tid & 63, wr = __builtin_amdgcn_readfirstlane(wid >> 1), wc = __builtin_amdgcn_readfirstlane(wid & 1);
  const int r = lane & 31, hh = lane >> 5, g1 = (lane >> 4) & 1, i16 = lane & 15, qd = i16 >> 2, pp = i16 & 3;
  const unsigned ldsb = (unsigned)(uintptr_t)lds;
  float* qsc = (float*)(lds + OFF_SC); float* ksc = qsc + 64;
  constexpr int NS = DVH >> 6, nitems = 32 * NS;
  const int bid = obid(), xcd = bid & 7, inx = bid >> 3;
  const bool g256 = (gridDim.x == 256);
  const bool active = g256 ? (inx < 4 * NS) : (bid < nitems);
  const int item = g256 ? ((xcd * 4 + inx / NS) * NS + inx % NS) : bid;
  const int slice = item % NS, dir = (item / NS) & 1, h = (item / (2 * NS)) & 3, b = item / (8 * NS);
  float econst = 1.f;
  if (active && ret) {
    const float lg = log_sigmoid_(gld<float>(a.decay + dir * 4 + h));
    econst = __expf(64.f * lg);
    if (tid < 64) { const float e = dir ? (float)(64 - tid) : (float)(tid + 1); qsc[tid] = __expf(lg * e); ksc[tid] = __expf(-lg * e); }
  }
  __syncthreads();
  const bf16_t* qg = (dir ? a.q1 : a.q0) + (size_t)b * L_ * LDQK + h * DK;
  const bf16_t* kg = (dir ? a.k1 : a.k0) + (size_t)b * L_ * LDQK + h * DK;
  const bf16_t* vg = a.v + (size_t)b * L_ * LDV + h * DVH + slice * 64;
  bf16_t* og = a.o + (size_t)b * L_ * LDO + h * DVH + slice * 64;
  const bf16_t* pg = a.P + ((size_t)(b * 128) * 4 + h) * 4096;
  const float* eg = ret ? nullptr : (a.E + (size_t)dir * (T_ / 64) * (4 * DK) + (size_t)(b * 128) * (4 * DK) + h * DK);
  f32x16 S[NT];
#pragma unroll
  for (int j = 0; j < NT; ++j)
#pragma unroll
    for (int e = 0; e < 16; ++e) S[j][e] = 0.f;
  struct Regs { u32x4 q[NQ], k[NQ], v, p; };
  Regs RA, RB;
  constexpr int DEPTH = (DK == 128) ? 2 : 1;
  float enext = 1.f;
  const int vrow = tid >> 3, vch = tid & 7;
  auto chunk_of = [&](int st) { const int s2 = st < 128 ? st : 127; return dir ? 127 - s2 : s2; };
  unsigned qoff[NQ];
#pragma unroll
  for (int i = 0; i < NQ; ++i) { const int c = tid + 512 * i, row = c / (DK / 8), ch = c % (DK / 8); qoff[i] = (unsigned)(row * LDQK + ch * 8) * 2u; }
  const unsigned voff = (unsigned)(vrow * LDV + vch * 8) * 2u, poff = (unsigned)(vrow * 64 + vch * 8) * 2u, ooff = (unsigned)(vrow * LDO + vch * 8) * 2u;
  auto issue = [&](Regs& R, int n) {
    const char* qb = (const char*)qg + (size_t)n * (64 * LDQK * 2);
    const char* kb2 = (const char*)kg + (size_t)n * (64 * LDQK * 2);
#pragma unroll
    for (int i = 0; i < NQ; ++i) { R.q[i] = gld<u32x4>(qb + qoff[i]); R.k[i] = gld<u32x4>(kb2 + qoff[i]); }
    R.v = gld<u32x4>((const char*)vg + (size_t)n * (64 * LDV * 2) + voff);
    R.p = gld<u32x4>((const char*)pg + (size_t)n * (4 * 4096 * 2) + poff);
  };
  auto issue1 = [&](int n1) { if (!ret) enext = gld<float>(eg + (size_t)n1 * (4 * DK) + (tid < DK ? tid : 0)); };
  auto step_fn = [&](Regs& R, int step, auto second_c) {
    constexpr bool second = decltype(second_c)::value;
    const int n = dir ? 127 - step : step;
    u32x4 ocur = {0u, 0u, 0u, 0u};
    if (second) ocur = gld<u32x4>((const char*)og + (size_t)n * (64 * LDO * 2) + ooff);
#pragma unroll
    for (int i = 0; i < NQ; ++i) {
      const int c = tid + 512 * i, row = c / (DK / 8), ch = c % (DK / 8);
      *(u32x4*)(lds + row * QS + ch * 16) = R.q[i];
      *(u32x4*)(lds + OFF_K + row * KS + ch * 16) = R.k[i];
    }
    *(u32x4*)(lds + OFF_V + vrow * VS + vch * 16) = ret ? scale8(R.v, ksc[vrow]) : R.v;
    {
      u32x4 w = R.p; unsigned ww[4] = {w.x, w.y, w.z, w.w};
#pragma unroll
      for (int e = 0; e < 4; ++e) {
        const int s0 = vch * 8 + 2 * e, s1 = s0 + 1;
        const bool k0 = dir ? (s0 > vrow) : (s0 <= vrow), k1 = dir ? (s1 > vrow) : (s1 <= vrow);
        ww[e] = (k0 ? (ww[e] & 0xffffu) : 0u) | (k1 ? (ww[e] & 0xffff0000u) : 0u);
      }
      *(u32x4*)(lds + OFF_PP + vrow * PS + vch * 16) = (u32x4){ww[0], ww[1], ww[2], ww[3]};
    }
    if (!ret) { if (tid < DK) *(float*)(lds + OFF_EE + tid * 4) = enext; }
    lds_barrier();
    issue(R, chunk_of(step + DEPTH));
    issue1(chunk_of(step + 1));
    bf16x8 vf[4];
    bf16x8 qa[2][2];
    auto ldq = [&](int jk, bf16x8 (&dst)[2]) {
      const int j = jk >> 1, ks = jk & 1;
#pragma unroll
      for (int tt = 0; tt < 2; ++tt) {
        const char* qp = lds + (32 * tt + r) * QS + (wr * RW + 32 * j + 16 * ks + 4 * hh) * 2;
        dst[tt] = cat8(*(const s16x4*)qp, *(const s16x4*)(qp + 16));
      }
    };
    f32x16 oacc[2];
    const f32x16 zero16 = {0.f, 0.f, 0.f, 0.f, 0.f, 0.f, 0.f, 0.f, 0.f, 0.f, 0.f, 0.f, 0.f, 0.f, 0.f, 0.f};
    {
      s16x4 t8[8];
      tr_issue8<4 * VS, 16 * VS>(ldsb + OFF_V + (8 * hh + qd) * VS + (32 * wc + 16 * g1 + 4 * pp) * 2, t8);
      const bf16x8 pa0 = *(const bf16x8*)(lds + OFF_PP + r * PS + (16 * wr + 8 * hh) * 2);
      const bf16x8 pa1 = *(const bf16x8*)(lds + OFF_PP + (32 + r) * PS + (16 * wr + 8 * hh) * 2);
      s16x4 tv[2];
      tr_issue2<4 * VS>(ldsb + OFF_V + (16 * wr + 8 * hh + qd) * VS + (32 * wc + 16 * g1 + 4 * pp) * 2, tv);
      ldq(0, qa[0]);
      tr_wait10(t8, tv);
#pragma unroll
      for (int s4 = 0; s4 < 4; ++s4) vf[s4] = cat8(t8[2 * s4], t8[2 * s4 + 1]);
      const bf16x8 vpv = cat8(tv[0], tv[1]);
      oacc[0] = __builtin_amdgcn_mfma_f32_32x32x16_bf16(pa0, vpv, zero16, 0, 0, 0);
      oacc[1] = __builtin_amdgcn_mfma_f32_32x32x16_bf16(pa1, vpv, zero16, 0, 0, 0);
    }
#pragma unroll
    for (int jk = 0; jk < 2 * NT; ++jk) {
      if (jk + 1 < 2 * NT) ldq(jk + 1, qa[(jk + 1) & 1]);
      __builtin_amdgcn_sched_barrier(0);
      const int j = jk >> 1, ks = jk & 1;
      u32x4 sb;
      sb.x = pk(S[j][8 * ks + 0], S[j][8 * ks + 1]); sb.y = pk(S[j][8 * ks + 2], S[j][8 * ks + 3]);
      sb.z = pk(S[j][8 * ks + 4], S[j][8 * ks + 5]); sb.w = pk(S[j][8 * ks + 6], S[j][8 * ks + 7]);
      const bf16x8 bfr = __builtin_bit_cast(bf16x8, sb);
      oacc[0] = __builtin_amdgcn_mfma_f32_32x32x16_bf16(qa[jk & 1][0], bfr, oacc[0], 0, 0, 0);
      oacc[1] = __builtin_amdgcn_mfma_f32_32x32x16_bf16(qa[jk & 1][1], bfr, oacc[1], 0, 0, 0);
      __builtin_amdgcn_sched_barrier(0);
    }
#pragma unroll
    for (int tt = 0; tt < 2; ++tt)
#pragma unroll
      for (int e = 0; e < 16; ++e) {
        const int t = 32 * tt + (e & 3) + 8 * (e >> 2) + 4 * hh;
        *(float*)(lds + OFF_O + ((wr * 64 + t) * 64 + 32 * wc + r) * 4) = oacc[tt][e];
      }
    {
      s16x4 ka[8], kb[8];
      tr_issue8<4 * KS, 16 * KS>(ldsb + OFF_K + (8 * hh + qd) * KS + (wr * RW + 16 * g1 + 4 * pp) * 2, ka);
      if (NT == 2) tr_issue8<4 * KS, 16 * KS>(ldsb + OFF_K + (8 * hh + qd) * KS + (wr * RW + 32 + 16 * g1 + 4 * pp) * 2, kb);
      if (NT == 2) tr_wait16(ka, kb); else tr_wait8(ka);
#pragma unroll
      for (int s4 = 0; s4 < 4; ++s4) {
        S[0] = __builtin_amdgcn_mfma_f32_32x32x16_bf16(cat8(ka[2 * s4], ka[2 * s4 + 1]), vf[s4], S[0], 0, 0, 0);
        if (NT == 2) S[NT - 1] = __builtin_amdgcn_mfma_f32_32x32x16_bf16(cat8(kb[2 * s4], kb[2 * s4 + 1]), vf[s4], S[NT - 1], 0, 0, 0);
      }
    }
#pragma unroll
    for (int j = 0; j < NT; ++j) {
      if (ret) {
#pragma unroll
        for (int e = 0; e < 16; ++e) S[j][e] *= econst;
      } else {
#pragma unroll
        for (int gq = 0; gq < 4; ++gq) {
          const f32x4 ev = *(const f32x4*)(lds + OFF_EE + (wr * RW + 32 * j + 8 * gq + 4 * hh) * 4);
#pragma unroll
          for (int e = 0; e < 4; ++e) S[j][4 * gq + e] *= ev[e];
        }
      }
    }
    lds_barrier();
    {
      float sum[8];
#pragma unroll
      for (int e = 0; e < 8; ++e) sum[e] = 0.f;
#pragma unroll
      for (int w4 = 0; w4 < 4; ++w4) {
        const float* op = (const float*)(lds + OFF_O + ((w4 * 64 + vrow) * 64 + vch * 8) * 4);
        const f32x4 x0 = *(const f32x4*)op, x1 = *(const f32x4*)(op + 4);
        sum[0] += x0[0]; sum[1] += x0[1]; sum[2] += x0[2]; sum[3] += x0[3]; sum[4] += x1[0]; sum[5] += x1[1]; sum[6] += x1[2]; sum[7] += x1[3];
      }
      if (ret) {
        const float myqs = qsc[vrow];
#pragma unroll
        for (int e = 0; e < 8; ++e) sum[e] *= myqs;
      }
      if (second) {
        sum[0] += bflo(ocur.x); sum[1] += bfhi(ocur.x); sum[2] += bflo(ocur.y); sum[3] += bfhi(ocur.y);
        sum[4] += bflo(ocur.z); sum[5] += bfhi(ocur.z); sum[6] += bflo(ocur.w); sum[7] += bfhi(ocur.w);
      }
      u32x4 w; w.x = pk(sum[0], sum[1]); w.y = pk(sum[2], sum[3]); w.z = pk(sum[4], sum[5]); w.w = pk(sum[6], sum[7]);
      gst<u32x4>((char*)og + (size_t)n * (64 * LDO * 2) + ooff, w);
      if (second) {
        float q2 = bflo(w.x) * bflo(w.x) + bfhi(w.x) * bfhi(w.x) + bflo(w.y) * bflo(w.y) + bfhi(w.y) * bfhi(w.y) +
                   bflo(w.z) * bflo(w.z) + bfhi(w.z) * bfhi(w.z) + bflo(w.w) * bflo(w.w) + bfhi(w.w) * bfhi(w.w);
        q2 += __shfl_xor(q2, 1); q2 += __shfl_xor(q2, 2); q2 += __shfl_xor(q2, 4);
        if (vch == 0) gst<float>(a.ssp + ((size_t)b * L_ + (size_t)n * 64 + vrow) * 32 + h * 8 + slice, q2);
      }
    }
  };
  if (active) {
    issue(RA, chunk_of(0)); issue1(chunk_of(0));
    if (DEPTH == 2) {
      issue(RB, chunk_of(1));
      for (int step = 0; step < 64; step += 2) { step_fn(RA, step, FalseC{}); step_fn(RB, step + 1, FalseC{}); }
    } else {
      for (int step = 0; step < 64; ++step) step_fn(RA, step, FalseC{});
    }
  }
  xcd_barrier(xb);
  if (active) {
    if (DEPTH == 2) {
      for (int step = 64; step < 128; step += 2) { step_fn(RA, step, TrueC{}); step_fn(RB, step + 1, TrueC{}); }
    } else {
      for (int step = 64; step < 128; ++step) step_fn(RA, step, TrueC{});
    }
  }
}

__global__ void __launch_bounds__(512, 2) mega(Params p) {
  cg::grid_group grid = cg::this_grid();
  extern __shared__ __attribute__((aligned(16))) char lds[];
  char* ws = KP(ws);
  volatile LAS unsigned* xst = (volatile LAS unsigned*)(LAS char*)(lds + (LDS_BYTES - 16));
  if (threadIdx.x == 0) { xst[0] = 0u; xst[1] = 0u; }
  __syncthreads();
  XcdBarrier xb = xcd_barrier_post((unsigned*)(ws + OFF_BAR), xst);
  rw_phase(KP(x), (bf16_t*)(ws + OFF_D), nullptr, nullptr, (float*)(ws + OFF_RS + 512 * 1024), nullptr, false);
  wconv_layer(0, (float*)lds);
  if (gridDim.x == 0x7fffffffu) grid.sync();
  xcd_barrier(xb);

  for (int layer = 0; layer < 4; ++layer) {
    const int kind0 = layer % 3;
    const int nsteps = (kind0 == 0 ? 6 : kind0 == 1 ? 4 : 7) + 3;
    const int nmix = nsteps - 3;
    for (int s = 0; s < nsteps; ++s) {
      int lyr = layer; asm volatile("" : "+s"(lyr));
      const int kind = (lyr == 3) ? 0 : lyr;
      char* ws = KP(ws);
      bf16_t* W = (bf16_t*)(ws + OFF_W);
      bf16_t* bA = (bf16_t*)(ws + OFF_A); bf16_t* bB = (bf16_t*)(ws + OFF_B); bf16_t* bC = (bf16_t*)(ws + OFF_C); bf16_t* bU = (bf16_t*)(ws + OFF_D);
      bf16_t* bP = (bf16_t*)(ws + OFF_P);
      float* rs = (float*)(ws + OFF_RS); float* Eb = (float*)(ws + OFF_E); float* t1 = (float*)(ws + OFF_T1);
      float* rh = (float*)(ws + OFF_RS + 512 * 1024);
      const float* G = KP(norm_gains);
      const float* gl = G + lyr * 4096;
      GemmDesc g{}; bool is_gemm = false;

      const int ms = s - nmix;
      if (ms == 0) { is_gemm = true; g.A = bU; g.Bt = W + W_UP; g.N = 4096; g.K = 1024; g.epi = EPI_RELU2; g.o0 = bA; g.rowscale = nullptr; }
      else if (ms == 1) { is_gemm = true; g.A = bA; g.Bt = W + W_DN; g.N = 1024; g.K = 4096; g.epi = EPI_PLAIN; g.o0 = bC; }
      else if (ms == 2) {
        rw_phase(nullptr, bU, bC, gl + 3072, rh, (lyr < 3) ? nullptr : KP(out), true);
        if (lyr < 3) wconv_layer(lyr + 1, (float*)lds);
      } else if (kind == 0) {
        const float* dec = KP(ret_decay) + (lyr / 3) * 8;
        if (s == 0) { is_gemm = true; g.A = bU; g.Bt = W + W_IN; g.N = 4096; g.K = 1024; g.epi = EPI_RETQKV; g.o0 = bA; g.o1 = bB; g.pos = KP(pos); g.rowscale = rh; }
        else if (s == 1) ppass_phase<256, false>(bA, bA + 1024, nullptr, nullptr, 2048, dec, bP);
        else if (s == 2) {
          ScanArgs a{}; a.q0 = a.q1 = bA; a.k0 = a.k1 = bA + 1024; a.v = bB; a.P = bP; a.o = bC;
          a.E = nullptr; a.decay = dec; a.ssp = t1;
          scan_phase<256>(a, lds, xb);
        }
        else if (s == 3) { is_gemm = true; g.A = bU; g.Bt = W + W_G; g.N = 2048; g.K = 1024; g.epi = EPI_GATE; g.dvshift = 9; g.o0 = bC; g.f0 = t1; g.c0 = nullptr; g.rowscale = rh; }
        else if (s == 4) { is_gemm = true; g.A = bC; g.Bt = W + W_OUT; g.N = 1024; g.K = 2048; g.epi = EPI_PLAIN; g.o0 = bA; }
        else rw_phase(nullptr, bU, bA, gl + 1024, rh, nullptr, false);
      } else if (kind == 1) {
        if (s == 0) { is_gemm = true; g.A = bU; g.Bt = W + W_IN; g.N = 2048; g.K = 1024; g.epi = EPI_GLU; g.o0 = bA; g.bias = KP(conv_b_in); g.rowscale = rh; }
        else if (s == 1) conv_phase(bA, bB, lds);
        else if (s == 2) { is_gemm = true; g.A = bB; g.Bt = W + W_OUT; g.N = 1024; g.K = 1024; g.epi = EPI_PLAIN; g.o0 = bC; g.bias = KP(conv_b_out); }
        else rw_phase(nullptr, bU, bC, gl + 1024, rh, nullptr, false);
      } else {
        bf16_t* gv = bA + (size_t)T_ * 1024; bf16_t* qkb = bB + (size_t)T_ * 1024; bf16_t* gy = bC + (size_t)T_ * 1024;
        if (s == 0) { is_gemm = true; g.A = bU; g.Bt = W + W_IN; g.N = 2304; g.K = 1024; g.epi = EPI_GLA; g.o0 = bA; g.o1 = gv; g.f0 = t1; g.rowscale = rh; }
        else if (s == 1) glaprep_phase(bA, t1, bB, qkb, Eb, lds);
        else if (s == 2) ppass_phase<128, true>(bB, bB + 512, qkb, qkb + 512, 1024, nullptr, bP);
        else if (s == 3) {
          ScanArgs a{}; a.q0 = bB; a.k0 = bB + 512; a.q1 = qkb; a.k1 = qkb + 512; a.v = gv; a.P = bP; a.o = bC;
          a.E = Eb; a.decay = nullptr; a.ssp = t1;
          scan_phase<128>(a, lds, xb);
        }
        else if (s == 4) { is_gemm = true; g.A = bU; g.Bt = W + W_G; g.N = 1024; g.K = 1024; g.epi = EPI_GATE; g.dvshift = 8; g.o0 = bC; g.f0 = t1; g.c0 = KP(gla_ng); g.rowscale = rh; }
        else if (s == 5) { is_gemm = true; g.A = bC; g.Bt = W + W_OUT; g.N = 1024; g.K = 1024; g.epi = EPI_PLAIN; g.o0 = gy; }
        else rw_phase(nullptr, bU, gy, gl + 1024, rh, nullptr, false);
      }
      if (is_gemm) gemm_phase(g, (LAS unsigned char*)lds);
      xcd_barrier(xb);
    }
  }
}

extern "C" void kernel_launch(void* const* d_in, const int* in_sizes, int n_in, void* d_out, int out_size,
                              void* d_ws, size_t ws_size, hipStream_t stream) {
  static int grid_blocks = 0;
  if (!grid_blocks) {
    (void)hipFuncSetAttribute((const void*)mega, hipFuncAttributeMaxDynamicSharedMemorySize, (int)LDS_BYTES);
    int dev = 0, cus = 0;
    (void)hipGetDevice(&dev);
    (void)hipDeviceGetAttribute(&cus, hipDeviceAttributeMultiprocessorCount, dev);
    grid_blocks = cus;
  }
  if (ws_size < 505 * MiB) { fprintf(stderr, "workspace too small: %zu\n", ws_size); return; }
  Params p{};
  p.x = (const float*)d_in[0]; p.pos = (const int*)d_in[1]; p.norm_gains = (const float*)d_in[2];
  p.ret_w_in = (const float*)d_in[3]; p.ret_decay = (const float*)d_in[4]; p.ret_w_out = (const float*)d_in[5];
  p.conv_w_in = (const float*)d_in[6]; p.conv_b_in = (const float*)d_in[7]; p.conv_w_dw = (const float*)d_in[8]; p.conv_b_dw = (const float*)d_in[9];
  p.conv_ln_g = (const float*)d_in[10]; p.conv_ln_b = (const float*)d_in[11]; p.conv_w_out = (const float*)d_in[12]; p.conv_b_out = (const float*)d_in[13];
  p.gla_w_in = (const float*)d_in[14]; p.gla_w1 = (const float*)d_in[15]; p.gla_w2 = (const float*)d_in[16]; p.gla_gb = (const float*)d_in[17];
  p.gla_ng = (const float*)d_in[18]; p.gla_w_out = (const float*)d_in[19]; p.mlp_up = (const float*)d_in[20]; p.mlp_down = (const float*)d_in[21];
  p.out = (float*)d_out; p.ws = (char*)d_ws;
  (void)hipMemsetAsync((char*)d_ws + OFF_BAR, 0, XCD_BAR_WORDS * 4, stream);
  void* args[] = {&p};
  hipError_t e = hipLaunchCooperativeKernel((void*)mega, dim3(grid_blocks), dim3(512), args, LDS_BYTES, stream);
  if (e != hipSuccess) fprintf(stderr, "cooperative launch failed: %s (grid %d)\n", hipGetErrorString(e), grid_blocks);
}
```
